# Optimizing an MI355X kernel written in HIP

```python
import jax
import jax.numpy as jnp
from jax import lax
import numpy as np

D_MODEL = 1024
BATCH = 32
SEQ = 256
DEPTH = 4
DEC_BATCH = 8
DEC_SEQ = 2048
PAST_LEN = 512

N_GROUPS = 4
GROUP_W = D_MODEL // N_GROUPS
HEAD_DIM = 64
CONV_CH = GROUP_W
CONV_WIDTH = 3
SGU_W = GROUP_W
SGU_HEADS = SGU_W // HEAD_DIM
CHUNK = 128
MLA_HEADS = 4
MLA_NOPE = 64
MLA_ROPE = 32
MLA_V = GROUP_W // MLA_HEADS
MLA_Q_LORA = D_MODEL // 4
MLA_KV_LORA = D_MODEL // 8
SWA_HEADS = GROUP_W // HEAD_DIM
SWA_KV_HEADS = 2
SWA_GROUP = SWA_HEADS // SWA_KV_HEADS
SWA_WINDOW = 128
SWA_BLOCK = 128
Q_BLOCK = 128
MLP_HIDDEN = 4 * D_MODEL
GRID_W = 64
ROPE_THETA = 10000.0
EPS = 1e-6
N_MOD = 6
IN_COLS = 3 * CONV_CH + 2 * SGU_W + MLA_Q_LORA + MLA_KV_LORA + MLA_ROPE + (SWA_HEADS + 2 * SWA_KV_HEADS) * HEAD_DIM
MLA_SCALE = (MLA_NOPE + MLA_ROPE) ** -0.5
SWA_SCALE = HEAD_DIM ** -0.5
NEG_INF = -1e30

kernel_name = 'hybrid_flow_prefix_step'


def rmsnorm(x, g):
    xf = x.astype(jnp.float32)
    y = xf * lax.rsqrt(jnp.mean(xf * xf, axis=-1, keepdims=True) + EPS)
    return (y * g.astype(jnp.float32)).astype(x.dtype)


def axial_rope_tables(n_tokens, rot_dim, dtype):
    rows = n_tokens // GRID_W
    row = jnp.repeat(jnp.arange(rows, dtype=jnp.float32), GRID_W)
    col = jnp.tile(jnp.arange(GRID_W, dtype=jnp.float32), rows)
    half = rot_dim // 2
    inv_freq = ROPE_THETA ** (-jnp.arange(0, half, 2, dtype=jnp.float32) / half)
    ang_r = row[:, None] * inv_freq[None, :]
    ang_c = col[:, None] * inv_freq[None, :]
    ang = jnp.concatenate([ang_r, ang_r, ang_c, ang_c], axis=-1)
    return jnp.cos(ang).astype(dtype), jnp.sin(ang).astype(dtype)


def apply_axial_rope(x, cos, sin):
    bshape = (cos.shape[0],) + (1,) * (x.ndim - 3) + (cos.shape[1],)
    cos = cos.reshape(bshape)
    sin = sin.reshape(bshape)
    x1, x2, x3, x4 = jnp.split(x, 4, axis=-1)
    rot = jnp.concatenate([-x2, x1, -x4, x3], axis=-1)
    return x * cos + rot * sin


def split_in_proj(z):
    sizes = (CONV_CH, CONV_CH, CONV_CH, 2 * SGU_W, MLA_Q_LORA, MLA_KV_LORA, MLA_ROPE,
             SWA_HEADS * HEAD_DIM, SWA_KV_HEADS * HEAD_DIM, SWA_KV_HEADS * HEAD_DIM)
    parts = []
    start = 0
    for size in sizes:
        parts.append(z[..., start:start + size])
        start += size
    return parts


def dwconv_centred(x, w):
    return lax.conv_general_dilated(
        x, w[:, None, :].astype(x.dtype), window_strides=(1,),
        padding=((CONV_WIDTH // 2, CONV_WIDTH // 2),),
        dimension_numbers=('NWC', 'WIO', 'NWC'), feature_group_count=x.shape[-1])


def chunk_sgu(uv, norm_g, w_s, b_s):
    z = jax.nn.gelu(uv)
    u, v = jnp.split(z, 2, axis=-1)
    v = rmsnorm(v, norm_g)
    bsz, n, _ = v.shape
    vh = v.reshape(bsz, n // CHUNK, CHUNK, SGU_HEADS, HEAD_DIM)
    sv = jnp.einsum('hpq,bcqhd->bcphd', w_s, vh) + b_s.T[None, None, :, :, None]
    return u * sv.reshape(bsz, n, SGU_W)


def mla_expand(c_kv, k_pe, w_kv_up):
    bsz, n, _ = c_kv.shape
    kv = (c_kv @ w_kv_up).reshape(bsz, n, MLA_HEADS, MLA_NOPE + MLA_V)
    k_nope, v = kv[..., :MLA_NOPE], kv[..., MLA_NOPE:]
    k_rope = jnp.broadcast_to(k_pe[:, :, None, :], (bsz, n, MLA_HEADS, MLA_ROPE))
    return jnp.concatenate([k_nope, k_rope], axis=-1), v


def blocked_attention(q, k, v, scale):
    bsz, n_q, n_h, d_k = q.shape
    qb = q.reshape(bsz, n_q // Q_BLOCK, Q_BLOCK, n_h, d_k).transpose(1, 0, 2, 3, 4)
    kf = k.astype(jnp.float32)

    def one_block(q_blk):
        s = jnp.einsum('bqhd,bkhd->bhqk', q_blk.astype(jnp.float32), kf) * scale
        p = jax.nn.softmax(s, axis=-1)
        return jnp.einsum('bhqk,bkhd->bqhd', p.astype(v.dtype), v)

    out = lax.map(one_block, qb)
    return out.transpose(1, 0, 2, 3, 4).reshape(bsz, n_q, n_h, v.shape[-1])


def sink_column(sink, like):
    col = sink.astype(jnp.float32).reshape(SWA_KV_HEADS, SWA_GROUP)[:, :, None, None]
    return jnp.broadcast_to(col, like.shape[:-1] + (1,))


def gqa_sink_blocked(q, k, v, sink):
    bsz, n_q = q.shape[:2]
    qb = q.reshape(bsz, n_q // Q_BLOCK, Q_BLOCK, SWA_KV_HEADS, SWA_GROUP, HEAD_DIM).transpose(1, 0, 2, 3, 4, 5)
    kf = k.astype(jnp.float32)

    def one_block(q_blk):
        s = jnp.einsum('bqngd,bsnd->bngqs', q_blk.astype(jnp.float32), kf) * SWA_SCALE
        p = jax.nn.softmax(jnp.concatenate([s, sink_column(sink, s)], axis=-1), axis=-1)[..., :-1]
        return jnp.einsum('bngqs,bsnd->bqngd', p.astype(v.dtype), v)

    out = lax.map(one_block, qb)
    return out.transpose(1, 0, 2, 3, 4, 5).reshape(bsz, n_q, SWA_HEADS * HEAD_DIM)


def banded_sink_attention(q, k, v, k_ctx, v_ctx, sink):
    bsz, n = q.shape[:2]
    nb = n // SWA_BLOCK
    qb = q.reshape(bsz, nb, SWA_BLOCK, SWA_KV_HEADS, SWA_GROUP, HEAD_DIM).astype(jnp.float32)

    def band(t):
        tb = t.reshape(bsz, nb, SWA_BLOCK, SWA_KV_HEADS, HEAD_DIM)
        zero = jnp.zeros_like(tb[:, :1])
        prev = jnp.concatenate([zero, tb[:, :-1]], axis=1)
        nxt = jnp.concatenate([tb[:, 1:], zero], axis=1)
        return jnp.concatenate([prev, tb, nxt], axis=2)

    k_band, v_band = band(k), band(v)
    blk = jnp.arange(nb)[:, None] * SWA_BLOCK
    q_pos = blk + jnp.arange(SWA_BLOCK)[None, :]
    k_pos = blk - SWA_BLOCK + jnp.arange(3 * SWA_BLOCK)[None, :]
    kp = k_pos[:, None, :]
    valid = (jnp.abs(q_pos[:, :, None] - kp) <= SWA_WINDOW) & (kp >= 0) & (kp < n)
    s_band = jnp.einsum('bcqngd,bcknd->bcngqk', qb, k_band.astype(jnp.float32)) * SWA_SCALE
    s_band = jnp.where(valid[None, :, None, None, :, :], s_band, NEG_INF)
    s_ctx = jnp.einsum('bcqngd,bsnd->bcngqs', qb, k_ctx.astype(jnp.float32)) * SWA_SCALE
    logits = jnp.concatenate([s_band, s_ctx, sink_column(sink, s_band)], axis=-1)
    p = jax.nn.softmax(logits, axis=-1).astype(v.dtype)
    n_band = 3 * SWA_BLOCK
    out = (jnp.einsum('bcngqk,bcknd->bcqngd', p[..., :n_band], v_band)
           + jnp.einsum('bcngqs,bsnd->bcqngd', p[..., n_band:-1], v_ctx))
    return out.reshape(bsz, n, SWA_HEADS * HEAD_DIM)


def mixer_front(h, p):
    bsz, n, _ = h.shape
    z = h @ p['w_in']
    a_b, a_c, a_x, sgu_uv, cq, ckv, k_pe, sq, sk, sv = split_in_proj(z)
    y_conv = a_b * dwconv_centred(a_c * a_x, p['conv_w'])
    y_sgu = chunk_sgu(sgu_uv, p['sgu_norm'], p['sgu_w'], p['sgu_b'])
    q_mla = (rmsnorm(cq, p['q_norm']) @ p['w_q_up']).reshape(bsz, n, MLA_HEADS, MLA_NOPE + MLA_ROPE)
    c_kv = rmsnorm(ckv, p['kv_norm'])
    q_swa = sq.reshape(bsz, n, SWA_KV_HEADS, SWA_GROUP, HEAD_DIM)
    k_swa = sk.reshape(bsz, n, SWA_KV_HEADS, HEAD_DIM)
    v_swa = sv.reshape(bsz, n, SWA_KV_HEADS, HEAD_DIM)
    return y_conv, y_sgu, q_mla, c_kv, k_pe, q_swa, k_swa, v_swa


def mix_context(h, p):
    bsz, n, _ = h.shape
    y_conv, y_sgu, q_mla, c_kv, k_pe, q_swa, k_swa, v_swa = mixer_front(h, p)
    k_mla, v_mla = mla_expand(c_kv, k_pe, p['w_kv_up'])
    y_mla = blocked_attention(q_mla, k_mla, v_mla, MLA_SCALE).reshape(bsz, n, MLA_HEADS * MLA_V)
    y_swa = gqa_sink_blocked(q_swa, k_swa, v_swa, p['sink'])
    y = jnp.concatenate([y_conv, y_sgu, y_mla, y_swa], axis=-1) @ p['w_out']
    return y, (c_kv, k_pe, k_swa, v_swa)


def mix_latent(h, p, ckv_ctx, kpe_ctx, k_ctx, v_ctx):
    bsz, n, _ = h.shape
    y_conv, y_sgu, q_mla, c_kv, k_pe, q_swa, k_swa, v_swa = mixer_front(h, p)
    cos_m, sin_m = axial_rope_tables(n, MLA_ROPE, h.dtype)
    q_mla = jnp.concatenate([q_mla[..., :MLA_NOPE], apply_axial_rope(q_mla[..., MLA_NOPE:], cos_m, sin_m)], axis=-1)
    k_lat, v_lat = mla_expand(c_kv, apply_axial_rope(k_pe, cos_m, sin_m), p['w_kv_up'])
    k_cm, v_cm = mla_expand(ckv_ctx, kpe_ctx, p['w_kv_up'])
    y_mla = blocked_attention(q_mla, jnp.concatenate([k_lat, k_cm], axis=1),
                              jnp.concatenate([v_lat, v_cm], axis=1), MLA_SCALE).reshape(bsz, n, MLA_HEADS * MLA_V)
    cos_s, sin_s = axial_rope_tables(n, HEAD_DIM, h.dtype)
    y_swa = banded_sink_attention(apply_axial_rope(q_swa, cos_s, sin_s), apply_axial_rope(k_swa, cos_s, sin_s),
                                  v_swa, k_ctx, v_ctx, p['sink'])
    return jnp.concatenate([y_conv, y_sgu, y_mla, y_swa], axis=-1) @ p['w_out']


def squared_relu_mlp(h, w1, w2):
    return jnp.square(jax.nn.relu(h @ w1)) @ w2


def modulate(x, g, shift, scale):
    return rmsnorm(x, g) * (1 + scale) + shift


def trunk_layer(x, mod, p, mix_fn):
    shift1, scale1, gate1, shift2, scale2, gate2 = jnp.split(mod, N_MOD, axis=-1)
    y, ctx_state = mix_fn(modulate(x, p['norm1'], shift1, scale1))
    x = x + gate1 * y
    x = x + gate2 * squared_relu_mlp(modulate(x, p['norm2'], shift2, scale2), p['w1'], p['w2'])
    return x, ctx_state


def setup_inputs(seed: int = 0) -> dict:
    key = jax.random.key(seed)
    ks = jax.random.split(key, 26)

    def nrm(k, shape, scale=1.0):
        return jax.random.normal(k, shape, dtype=jnp.float32) * scale

    def gain(k, shape):
        return 1.0 + 0.02 * jax.random.normal(k, shape, dtype=jnp.float32)

    return {
        'x_prompt': nrm(ks[0], (BATCH, SEQ, D_MODEL)),
        'x_sample': nrm(ks[1], (DEC_BATCH, DEC_SEQ, D_MODEL)),
        'cache_mla_ckv': nrm(ks[2], (DEC_BATCH, DEPTH, PAST_LEN, MLA_KV_LORA)),
        'cache_mla_kpe': nrm(ks[3], (DEC_BATCH, DEPTH, PAST_LEN, MLA_ROPE)),
        'cache_swa_k': nrm(ks[4], (DEC_BATCH, DEPTH, PAST_LEN, SWA_KV_HEADS, HEAD_DIM)),
        'cache_swa_v': nrm(ks[5], (DEC_BATCH, DEPTH, PAST_LEN, SWA_KV_HEADS, HEAD_DIM)),
        'c': nrm(ks[6], (DEC_BATCH, D_MODEL)),
        'c_ctx': nrm(ks[7], (D_MODEL,)),
        'w_ada': nrm(ks[8], (DEPTH, D_MODEL, N_MOD * D_MODEL), 0.5 * D_MODEL ** -0.5),
        'b_ada': nrm(ks[9], (DEPTH, N_MOD * D_MODEL), 0.01),
        'norm1': gain(ks[10], (DEPTH, D_MODEL)),
        'norm2': gain(ks[11], (DEPTH, D_MODEL)),
        'w_in': nrm(ks[12], (DEPTH, D_MODEL, IN_COLS), D_MODEL ** -0.5),
        'conv_w': nrm(ks[13], (DEPTH, CONV_WIDTH, CONV_CH), CONV_WIDTH ** -0.5),
        'sgu_norm': gain(ks[14], (DEPTH, SGU_W)),
        'sgu_w': nrm(ks[15], (DEPTH, SGU_HEADS, CHUNK, CHUNK), CHUNK ** -0.5),
        'sgu_b': nrm(ks[16], (DEPTH, SGU_HEADS, CHUNK), 0.02),
        'mla_q_norm': gain(ks[17], (DEPTH, MLA_Q_LORA)),
        'mla_w_q_up': nrm(ks[18], (DEPTH, MLA_Q_LORA, MLA_HEADS * (MLA_NOPE + MLA_ROPE)), MLA_Q_LORA ** -0.5),
        'mla_kv_norm': gain(ks[19], (DEPTH, MLA_KV_LORA)),
        'mla_w_kv_up': nrm(ks[20], (DEPTH, MLA_KV_LORA, MLA_HEADS * (MLA_NOPE + MLA_V)), MLA_KV_LORA ** -0.5),
        'swa_sink': nrm(ks[21], (DEPTH, SWA_HEADS)),
        'w_out': nrm(ks[22], (DEPTH, D_MODEL, D_MODEL), D_MODEL ** -0.5),
        'mlp_w1': nrm(ks[23], (DEPTH, D_MODEL, MLP_HIDDEN), D_MODEL ** -0.5),
        'mlp_w2': nrm(ks[24], (DEPTH, MLP_HIDDEN, D_MODEL), MLP_HIDDEN ** -0.5),
        'final_norm': gain(ks[25], (D_MODEL,)),
    }


def reference(x_prompt, x_sample, cache_mla_ckv, cache_mla_kpe, cache_swa_k, cache_swa_v, c, c_ctx,
              w_ada, b_ada, norm1, norm2, w_in, conv_w, sgu_norm, sgu_w, sgu_b, mla_q_norm, mla_w_q_up,
              mla_kv_norm, mla_w_kv_up, swa_sink, w_out, mlp_w1, mlp_w2, final_norm):
    xp = x_prompt
    xs = x_sample
    ckv_list, kpe_list, k_list, v_list = [], [], [], []
    for l in range(DEPTH):
        p = {'norm1': norm1[l], 'norm2': norm2[l], 'w_in': w_in[l], 'conv_w': conv_w[l],
             'sgu_norm': sgu_norm[l], 'sgu_w': sgu_w[l], 'sgu_b': sgu_b[l], 'q_norm': mla_q_norm[l],
             'w_q_up': mla_w_q_up[l], 'kv_norm': mla_kv_norm[l], 'w_kv_up': mla_w_kv_up[l],
             'sink': swa_sink[l], 'w_out': w_out[l], 'w1': mlp_w1[l], 'w2': mlp_w2[l]}
        mod_ctx = (jax.nn.silu(c_ctx) @ w_ada[l] + b_ada[l])[None, None, :]
        mod_lat = (jax.nn.silu(c) @ w_ada[l] + b_ada[l])[:, None, :]
        xp, (ckv_l, kpe_l, k_l, v_l) = trunk_layer(xp, mod_ctx, p, lambda h, p=p: mix_context(h, p))
        ckv_list.append(ckv_l)
        kpe_list.append(kpe_l)
        k_list.append(k_l)
        v_list.append(v_l)
        xs, _ = trunk_layer(
            xs, mod_lat, p,
            lambda h, p=p, l=l: (mix_latent(h, p, cache_mla_ckv[:, l], cache_mla_kpe[:, l],
                                            cache_swa_k[:, l], cache_swa_v[:, l]), None))
    y_prompt = rmsnorm(xp, final_norm)
    y_sample = rmsnorm(xs, final_norm)
    new_mla_ckv = jnp.stack(ckv_list, axis=1)
    new_mla_kpe = jnp.stack(kpe_list, axis=1)
    new_swa_k = jnp.stack(k_list, axis=1)
    new_swa_v = jnp.stack(v_list, axis=1)
    return (y_prompt, y_sample, new_mla_ckv, new_mla_kpe, new_swa_k, new_swa_v)
```

```cpp
#include <hip/hip_runtime.h>
#include <hip/hip_cooperative_groups.h>
#include <cstdio>
#include <cstdint>
#include <cstring>
namespace cg = cooperative_groups;
__device__ __forceinline__ int otid() { int t = threadIdx.x; asm volatile("" : "+v"(t)); return t; }
__device__ __forceinline__ int obx() { int t = blockIdx.x; asm volatile("" : "+s"(t)); return t; }
__device__ __forceinline__ int ogx() { int t = gridDim.x; asm volatile("" : "+s"(t)); return t; }
namespace pg8 {
#define PG8_LAS __attribute__((address_space(3)))
typedef unsigned short bf16_t;
typedef short bf16x8 __attribute__((ext_vector_type(8)));
typedef float f32x4 __attribute__((ext_vector_type(4)));
typedef unsigned u32x4 __attribute__((ext_vector_type(4)));
constexpr int BM = 256, BK = 64, HALF = 128, HTB = HALF * BK * 2  , STAGE_BYTES = 8 * HTB, NXCD = 8, WGM = 8;

__host__ __device__ __forceinline__ int lds_byte(int r, int c) { const int st = (r >> 4) * 2 + (c >> 5), rr = r & 15, cc = c & 31, ob = rr * 64 + cc * 2; return st * 1024 + (ob ^ (((ob >> 9) & 1) << 5)); }
__host__ __device__ __forceinline__ void stage_rc(int b, int& R, int& C) { const int st = b / 1024, sb = b % 1024, swz = sb ^ (((sb >> 9) & 1) << 5); R = (st >> 1) * 16 + swz / 64; C = (st & 1) * 32 + (swz % 64) / 2; }
__host__ __device__ __forceinline__ int perm32(int rho) { const int n = rho >> 4, i = rho & 15; return 8 * (i >> 2) + 4 * n + (i & 3); }

struct Unit { int pm, pn, kh; };
struct Gemm { const bf16_t* A; const bf16_t* Bt; int M, N, K, ksub; };

struct StaticOrder {
    int nM, nN, nwg, G, c;
    __host__ __device__ void init(int M, int N, int G_, int c_) { nM = M / BM; nN = N / BM; nwg = nM * nN; G = G_; c = c_; }
    __host__ __device__ bool next(int i, Unit& u) const {
        const long L = (long)i * G + c; if (L >= nwg) return false;
        int wgid = (int)L; { const int q = nwg / NXCD, r = nwg % NXCD, xcd = wgid % NXCD, off = wgid / NXCD; wgid = (xcd < r ? xcd * (q + 1) : r * (q + 1) + (xcd - r) * q) + off; }
        const int nig = WGM * nN, gid = wgid / nig, fm = gid * WGM, gsz = (nM - fm) < WGM ? (nM - fm) : WGM;
        u.pm = fm + ((wgid % nig) % gsz); u.pn = (wgid % nig) / gsz; u.kh = 0; return true;
    }
    __device__ __forceinline__ void a_ready(const Unit&) const {}
    __device__ __forceinline__ void done(const Unit&) const {}
};

template <int ROUND> struct TailSplitOrder {
    int c;
    __host__ __device__ void init(int c_) { c = c_; }
    __host__ __device__ bool next(int i, Unit& u) const {
        if (i != 0) return false;
        const int vc = (c % 8) * 32 + c / 8;
        if (ROUND == 0) { u.pm = vc >> 2; u.pn = vc & 3; u.kh = 0; }
        else { const int un = vc >> 1; u.pm = 64 + (un >> 2); u.pn = un & 3; u.kh = vc & 1; }
        return true;
    }
    __device__ __forceinline__ void a_ready(const Unit&) const {}
    __device__ __forceinline__ void done(const Unit&) const {}
};
__device__ __forceinline__ unsigned cvt_pk_bf16(float lo, float hi) { unsigned r; asm volatile("v_cvt_pk_bf16_f32 %0, %1, %2" : "=v"(r) : "v"(lo), "v"(hi)); return r; }
template <class Epi, class Sched, bool ALIGN_EPI = false, bool SP2 = false>
__device__ __forceinline__ void gemm_phase(PG8_LAS unsigned char* lds, const Gemm g, const Sched& S, const Epi& E) {
    const int tid = otid(), wid = __builtin_amdgcn_readfirstlane(tid >> 6), lane = tid & 63, wr = wid >> 2, wc = wid & 3, fr = lane & 15, fq = lane >> 4;
    const int K = g.K, nt = (g.ksub ? g.ksub : K) / BK; const size_t kpart = (size_t)g.ksub * 2;
    unsigned voffA[2], voffB[2];
#pragma unroll
    for (int i = 0; i < 2; ++i) { int R, C; stage_rc(tid * 16 + i * 8192, R, C); const int Rb = Epi::PERM ? ((R & ~31) + perm32(R & 31)) : R;
        voffA[i] = (unsigned)(R * K + C) * 2u; voffB[i] = (unsigned)(Rb * K + C) * 2u; }
    const size_t kstep = (size_t)(BK * 2);
    const size_t hstep = (size_t)HALF * K * 2;
    const size_t tstep = 2 * hstep;
    const unsigned ldsw = (unsigned)wid * 1024u;
    const int aoff = lds_byte(wr * 64 + fr, fq * 8), boff = lds_byte(wc * 32 + fr, fq * 8);
#define PG8_SA(b, h) (((b) * 2 + (h)) * HTB)
#define PG8_SB(b, h) ((4 + (b) * 2 + (h)) * HTB)
#define PG8_STAGE(bufoff, gbase, voff) do { _Pragma("unroll") for (int _i = 0; _i < 2; ++_i) \
        __builtin_amdgcn_global_load_lds((const unsigned*)((const char*)(gbase) + (voff)[_i]), (PG8_LAS unsigned*)(lds + (bufoff) + ldsw + _i * 8192), 16, 0, 0); } while (0)
#define PG8_LDA(dst, b, h) do { _Pragma("unroll") for (int m = 0; m < 4; ++m) _Pragma("unroll") for (int k = 0; k < 2; ++k) dst[m][k] = *(const PG8_LAS bf16x8*)(lds + PG8_SA(b, h) + aoff + m * 2048 + k * 1024); } while (0)
#define PG8_LDB(dst, b, h) do { _Pragma("unroll") for (int n = 0; n < 2; ++n) _Pragma("unroll") for (int k = 0; k < 2; ++k) dst[n][k] = *(const PG8_LAS bf16x8*)(lds + PG8_SB(b, h) + boff + n * 2048 + k * 1024); } while (0)
#define PG8_MMA(ai, bj, At, Bt) do { __builtin_amdgcn_s_setprio(1); _Pragma("unroll") for (int m = 0; m < 4; ++m) _Pragma("unroll") for (int n = 0; n < 2; ++n) _Pragma("unroll") for (int k = 0; k < 2; ++k) \
        acc[ai][bj][m][n] = __builtin_amdgcn_mfma_f32_16x16x32_bf16(Bt[n][k], At[m][k], acc[ai][bj][m][n], 0, 0, 0); __builtin_amdgcn_s_setprio(0); } while (0)
#define PG8_WAIT_V(n) asm volatile("s_waitcnt vmcnt(" #n ")" ::: "memory")
#define PG8_WAIT_L(n) asm volatile("s_waitcnt lgkmcnt(" #n ")" ::: "memory")
#define PG8_BAR __builtin_amdgcn_s_barrier()
#define PG8_SCHED __builtin_amdgcn_sched_barrier(0)
    Unit cur, nxt; int ui = 0;
    if (!S.next(0, cur)) return;
    f32x4 acc[2][2][4][2];
#pragma unroll
    for (int a = 0; a < 2; ++a)
#pragma unroll
        for (int b = 0; b < 2; ++b)
#pragma unroll
            for (int m = 0; m < 4; ++m)
#pragma unroll
                for (int n = 0; n < 2; ++n) acc[a][b][m][n] = (f32x4){0.f, 0.f, 0.f, 0.f};
    bf16x8 At[4][2], B0[2][2], B1[2][2];
    const char* cA = (const char*)g.A + (size_t)cur.pm * tstep + (size_t)cur.kh * kpart; const char* cB = (const char*)g.Bt + (size_t)cur.pn * tstep + (size_t)cur.kh * kpart;
    S.a_ready(cur);
    if constexpr (SP2) {
        PG8_STAGE(PG8_SB(0, 0), cB, voffB); PG8_STAGE(PG8_SB(0, 1), cB + hstep, voffB); PG8_STAGE(PG8_SA(0, 0), cA, voffA); PG8_STAGE(PG8_SA(0, 1), cA + hstep, voffA);
        if (wr == 1) PG8_BAR;
        PG8_WAIT_V(2); PG8_BAR;
        PG8_STAGE(PG8_SB(1, 0), cB + kstep, voffB); PG8_STAGE(PG8_SA(1, 0), cA + kstep, voffA); PG8_STAGE(PG8_SB(1, 1), cB + hstep + kstep, voffB);
        PG8_WAIT_V(6); PG8_BAR;
    } else {
        PG8_STAGE(PG8_SB(0, 0), cB, voffB); PG8_STAGE(PG8_SA(0, 0), cA, voffA); PG8_STAGE(PG8_SB(0, 1), cB + hstep, voffB); PG8_STAGE(PG8_SA(0, 1), cA + hstep, voffA);
        if (wr == 1) PG8_BAR;
        PG8_WAIT_V(4); PG8_BAR;
        PG8_STAGE(PG8_SB(1, 0), cB + kstep, voffB); PG8_STAGE(PG8_SA(1, 0), cA + kstep, voffA); PG8_STAGE(PG8_SB(1, 1), cB + hstep + kstep, voffB);
        PG8_WAIT_V(6); PG8_BAR;
    }
    for (;;) {
        const bool has_next = S.next(ui + 1, nxt);
        const char* nA = has_next ? (const char*)g.A + (size_t)nxt.pm * tstep + (size_t)nxt.kh * kpart : cA; const char* nB = has_next ? (const char*)g.Bt + (size_t)nxt.pn * tstep + (size_t)nxt.kh * kpart : cB;
        for (int t = 0; t < nt; t += 2) {
            const bool last = (t == nt - 2);
            const char* a1 = cA + (size_t)(t + 1) * kstep;
            const char* a2 = last ? nA : cA + (size_t)(t + 2) * kstep; const char* b2 = last ? nB : cB + (size_t)(t + 2) * kstep;
            const char* a3 = a2 + kstep; const char* b3 = b2 + kstep;
            if (last && has_next) S.a_ready(nxt);
            if constexpr (SP2) {
            PG8_LDB(B0, 0, 0); PG8_LDB(B1, 0, 1); PG8_SCHED; PG8_LDA(At, 0, 0); PG8_STAGE(PG8_SA(1, 1), a1 + hstep, voffA);
            PG8_WAIT_V(8); PG8_WAIT_L(0); PG8_BAR; PG8_MMA(0, 0, At, B0); PG8_MMA(0, 1, At, B1); PG8_BAR; PG8_SCHED;
            PG8_LDA(At, 0, 1); PG8_STAGE(PG8_SB(0, 0), b2, voffB); PG8_STAGE(PG8_SB(0, 1), b2 + hstep, voffB); PG8_STAGE(PG8_SA(0, 0), a2, voffA);
            PG8_WAIT_V(8); PG8_WAIT_L(0); PG8_BAR; PG8_MMA(1, 0, At, B0); PG8_MMA(1, 1, At, B1); PG8_BAR; PG8_SCHED;
            PG8_LDB(B0, 1, 0); PG8_LDB(B1, 1, 1); PG8_SCHED; PG8_LDA(At, 1, 0); PG8_STAGE(PG8_SA(0, 1), a2 + hstep, voffA);
            PG8_WAIT_V(8); PG8_WAIT_L(0); PG8_BAR; PG8_MMA(0, 0, At, B0); PG8_MMA(0, 1, At, B1); PG8_BAR; PG8_SCHED;
            PG8_LDA(At, 1, 1); PG8_STAGE(PG8_SB(1, 0), b3, voffB); PG8_STAGE(PG8_SB(1, 1), b3 + hstep, voffB); PG8_STAGE(PG8_SA(1, 0), a3, voffA);
            PG8_WAIT_V(8); PG8_WAIT_L(0); PG8_BAR; PG8_MMA(1, 0, At, B0); PG8_MMA(1, 1, At, B1); PG8_BAR; PG8_SCHED;
            } else {
            PG8_LDB(B0, 0, 0); PG8_SCHED; PG8_LDA(At, 0, 0); PG8_STAGE(PG8_SA(1, 1), a1 + hstep, voffA);
            PG8_WAIT_L(8); PG8_BAR; PG8_WAIT_L(0); PG8_MMA(0, 0, At, B0); PG8_BAR; PG8_SCHED;
            PG8_LDB(B1, 0, 1); PG8_STAGE(PG8_SB(0, 0), b2, voffB);
            PG8_BAR; PG8_WAIT_L(0); PG8_MMA(0, 1, At, B1); PG8_BAR;
            PG8_LDA(At, 0, 1); PG8_STAGE(PG8_SA(0, 0), a2, voffA);
            PG8_BAR; PG8_WAIT_L(0); PG8_MMA(1, 0, At, B0); PG8_BAR; PG8_SCHED;
            PG8_STAGE(PG8_SB(0, 1), b2 + hstep, voffB);
            PG8_WAIT_V(6); PG8_BAR; PG8_MMA(1, 1, At, B1); PG8_BAR;
            PG8_LDB(B0, 1, 0); PG8_SCHED; PG8_LDA(At, 1, 0); PG8_STAGE(PG8_SA(0, 1), a2 + hstep, voffA);
            PG8_WAIT_L(8); PG8_BAR; PG8_WAIT_L(0); PG8_MMA(0, 0, At, B0); PG8_BAR; PG8_SCHED;
            PG8_LDB(B1, 1, 1); PG8_STAGE(PG8_SB(1, 0), b3, voffB);
            PG8_BAR; PG8_WAIT_L(0); PG8_MMA(0, 1, At, B1); PG8_BAR;
            PG8_LDA(At, 1, 1); PG8_STAGE(PG8_SA(1, 0), a3, voffA);
            PG8_BAR; PG8_WAIT_L(0); PG8_MMA(1, 0, At, B0); PG8_BAR; PG8_SCHED;
            PG8_STAGE(PG8_SB(1, 1), b3 + hstep, voffB);
            PG8_WAIT_V(6); PG8_BAR; PG8_MMA(1, 1, At, B1); PG8_BAR;
            }
        }
        if constexpr (ALIGN_EPI) { if (wr == 0) PG8_BAR; }
        if constexpr (!Epi::AFTER_DRAIN) { E(acc, cur, wr, wc, fr, fq); S.done(cur); }
        if (!has_next) break;
    #pragma unroll
        for (int a = 0; a < 2; ++a)
#pragma unroll
            for (int b = 0; b < 2; ++b)
#pragma unroll
                for (int m = 0; m < 4; ++m)
#pragma unroll
                    for (int n = 0; n < 2; ++n) acc[a][b][m][n] = (f32x4){0.f, 0.f, 0.f, 0.f};
        cur = nxt; cA = nA; cB = nB; ++ui;
        if constexpr (ALIGN_EPI) { if (wr == 1) PG8_BAR; }
    }
    PG8_WAIT_V(0);
    if constexpr (!ALIGN_EPI) { if (wr == 0) PG8_BAR; }
    PG8_BAR;
    if constexpr (Epi::AFTER_DRAIN) { E.fused(acc, cur, wr, wc, fr, fq, lds, wid, lane); S.done(cur); }
#undef PG8_SA
#undef PG8_SB
#undef PG8_STAGE
#undef PG8_LDA
#undef PG8_LDB
#undef PG8_MMA
#undef PG8_WAIT_V
#undef PG8_WAIT_L
#undef PG8_BAR
#undef PG8_SCHED
}
}

typedef unsigned short bf16;
typedef short bf16x8 __attribute__((ext_vector_type(8)));
typedef float f32x4 __attribute__((ext_vector_type(4)));
typedef float f32x16 __attribute__((ext_vector_type(16)));
typedef unsigned u32x4 __attribute__((ext_vector_type(4)));
typedef unsigned u32x2 __attribute__((ext_vector_type(2)));
typedef short s16x4 __attribute__((ext_vector_type(4)));
#define LAS __attribute__((address_space(3)))

constexpr int DM = 1024, T_CTX = 8192, T_LAT = 16384, TT = T_CTX + T_LAT, NL = 4;
constexpr int S_CTX = 256, S_LAT = 2048, B_CTX = 32, B_LAT = 8, PAST = 512;
constexpr int NZ = 2304, KVROWS = TT + B_LAT * PAST;
constexpr int HID = 4096;
constexpr float EPSN = 1e-6f;
constexpr float LOG2E = 1.4426950408889634f;
constexpr int ZC_AB = 0, ZC_AC = 256, ZC_AX = 512, ZC_U = 768, ZC_V = 1024, ZC_CQ = 1280, ZC_CKV = 1536, ZC_KPE = 1664, ZC_SQ = 1792, ZC_SK = 2048, ZC_SV = 2176;
enum { I_XP = 0, I_XS, I_CCKV, I_CKPE, I_CSK, I_CSV, I_C, I_CCTX, I_WADA, I_BADA, I_N1, I_N2, I_WIN, I_CONVW, I_SGUN, I_SGUW, I_SGUB, I_QN, I_WQUP, I_KVN, I_WKVUP, I_SINK, I_WOUT, I_W1, I_W2, I_FN };
constexpr size_t O_X = 0, O_CKV = (size_t)TT * DM, O_KPE = O_CKV + (size_t)B_CTX * NL * S_CTX * 128, O_SK = O_KPE + (size_t)B_CTX * NL * S_CTX * 32, O_SV = O_SK + (size_t)B_CTX * NL * S_CTX * 128;
constexpr size_t MiB = 1u << 20;
constexpr size_t WS_MOD = 0, WS_BAR = 896 * 1024;
constexpr size_t WSET = 23 * MiB;
constexpr size_t WS_WIN = 1 * MiB, WS_WOUT = WS_WIN + 4608 * 1024, WS_W1 = WS_WOUT + 2 * MiB, WS_W2 = WS_W1 + 8 * MiB, WS_WQ = WS_W2 + 8 * MiB, WS_WKV = WS_WQ + 256 * 1024, WS_WSGU = WS_WKV + 128 * 1024;
static_assert(WS_WSGU + 128 * 1024 <= 1 * MiB + WSET, "weight set size");
constexpr size_t WS_H = 47 * MiB, BIG0 = 95 * MiB;
constexpr size_t WS_Z = BIG0, WS_YCAT = BIG0 + 108 * MiB, WS_QMLA = BIG0 + 156 * MiB, WS_KVMLA = BIG0 + 180 * MiB, WS_CQN = BIG0 + 208 * MiB, WS_CKV = BIG0 + 220 * MiB, WS_KPE = BIG0 + 227 * MiB,
                 WS_QSWA = BIG0 + 229 * MiB, WS_KSWA = BIG0 + 241 * MiB, WS_VSWA = BIG0 + 248 * MiB, WS_HID = BIG0, WS_X16 = BIG0 + 255 * MiB, WS_PART = BIG0 + 192 * MiB, WS_END = BIG0 + 303 * MiB;
static_assert(WS_END <= 400 * MiB, "workspace budget");
constexpr int LDS_BYTES = 147456;
constexpr int NPHASE = 38;

struct Params { const float* in[26]; float* out; unsigned char* ws; int ph_lo, ph_hi; };
typedef const __attribute__((address_space(4))) Params CPAR;

__device__ __forceinline__ unsigned pk2(float lo, float hi) { return pg8::cvt_pk_bf16(lo, hi); }
__device__ __forceinline__ float bflo(unsigned w) { return __uint_as_float(w << 16); }
__device__ __forceinline__ float bfhi(unsigned w) { return __uint_as_float(w & 0xffff0000u); }
__device__ __forceinline__ float wave_sum(float v) {
#pragma unroll
    for (int o = 1; o < 64; o <<= 1) v += __shfl_xor(v, o);
    return v;
}
__device__ __forceinline__ int crow(int r, int hi) { return (r & 3) + 8 * (r >> 2) + 4 * hi; }
__device__ __forceinline__ int mod_idx(int t) { return t < T_CTX ? 0 : 1 + ((t - T_CTX) >> 11); }
__device__ __forceinline__ float gelu_tanh(float x) {
    const float y = 0.7978845608028654f * (x + 0.044715f * x * x * x);
    const float e = __expf(2.f * y);
    const float th = 1.f - 2.f / (e + 1.f);
    return 0.5f * x * (1.f + th);
}
__device__ __forceinline__ void sincos_red(float a, float& s, float& c) {
    const float k = rintf(a * 0.15915494309189535f);
    float r = fmaf(-k, 6.28318548202514648f, a);
    r = fmaf(-k, -1.7484555e-7f, r);
    s = __sinf(r); c = __cosf(r);
}

template <int ACT> struct EpiStore {
    static constexpr bool PERM = true, AFTER_DRAIN = false;
    bf16* O; int ldc;
    __device__ __forceinline__ void operator()(const f32x4 (&acc)[2][2][4][2], const pg8::Unit& u, int wr, int wc, int fr, int fq) const {
        const int row0 = u.pm * 256 + wr * 64 + fr, col0 = u.pn * 256 + wc * 32 + 8 * fq;
#pragma unroll
        for (int ai = 0; ai < 2; ++ai)
#pragma unroll
            for (int m = 0; m < 4; ++m) {
                bf16* rowp = O + (size_t)(row0 + ai * 128 + m * 16) * ldc + col0;
#pragma unroll
                for (int bj = 0; bj < 2; ++bj) {
                    f32x4 v0 = acc[ai][bj][m][0], v1 = acc[ai][bj][m][1];
                    if (ACT == 1) {
#pragma unroll
                        for (int j = 0; j < 4; ++j) { const float a = fmaxf(v0[j], 0.f), b = fmaxf(v1[j], 0.f); v0[j] = a * a; v1[j] = b * b; }
                    }
                    u32x4 w; w.x = pk2(v0[0], v0[1]); w.y = pk2(v0[2], v0[3]); w.z = pk2(v1[0], v1[1]); w.w = pk2(v1[2], v1[3]);
                    *(u32x4*)(rowp + bj * 128) = w;
                }
            }
    }
};
constexpr int SPLIT_ROW0 = 16384;
struct EpiRes {
    static constexpr bool PERM = true, AFTER_DRAIN = false;
    bf16* X; const float* gate_base; bf16* PART;
    __device__ __forceinline__ void operator()(const f32x4 (&acc)[2][2][4][2], const pg8::Unit& u, int wr, int wc, int fr, int fq) const {
        const int row0 = u.pm * 256 + wr * 64 + fr, col0 = u.pn * 256 + wc * 32 + 8 * fq;
        const float* gate = gate_base + (size_t)mod_idx(u.pm * 256) * 6144 + col0;
        f32x4 gv[2][2];
#pragma unroll
        for (int bj = 0; bj < 2; ++bj)
#pragma unroll
            for (int n = 0; n < 2; ++n) gv[bj][n] = *(const f32x4*)(gate + bj * 128 + 4 * n);
        if (u.kh != 0) {
            bf16* Pr = PART + (size_t)(row0 - SPLIT_ROW0) * DM + col0;
#pragma unroll
            for (int ai = 0; ai < 2; ++ai)
#pragma unroll
                for (int m = 0; m < 4; ++m)
#pragma unroll
                    for (int bj = 0; bj < 2; ++bj) {
                        const f32x4 a0 = acc[ai][bj][m][0] * gv[bj][0], a1 = acc[ai][bj][m][1] * gv[bj][1];
                        u32x4 w; w.x = pk2(a0[0], a0[1]); w.y = pk2(a0[2], a0[3]); w.z = pk2(a1[0], a1[1]); w.w = pk2(a1[2], a1[3]);
                        *(u32x4*)(Pr + (size_t)(ai * 128 + m * 16) * DM + bj * 128) = w;
                    }
            return;
        }
        bf16* Xr = X + (size_t)row0 * DM + col0;
        u32x4 xin[2][4][2];
#pragma unroll
        for (int ai = 0; ai < 2; ++ai)
#pragma unroll
            for (int m = 0; m < 4; ++m)
#pragma unroll
                for (int bj = 0; bj < 2; ++bj) xin[ai][m][bj] = *(const u32x4*)(Xr + (size_t)(ai * 128 + m * 16) * DM + bj * 128);
#pragma unroll
        for (int ai = 0; ai < 2; ++ai)
#pragma unroll
            for (int m = 0; m < 4; ++m)
#pragma unroll
                for (int bj = 0; bj < 2; ++bj) {
                    const u32x4 xi = xin[ai][m][bj];
                    const f32x4 a0 = acc[ai][bj][m][0] * gv[bj][0], a1 = acc[ai][bj][m][1] * gv[bj][1];
                    u32x4 w;
                    w.x = pk2(bflo(xi.x) + a0[0], bfhi(xi.x) + a0[1]); w.y = pk2(bflo(xi.y) + a0[2], bfhi(xi.y) + a0[3]);
                    w.z = pk2(bflo(xi.z) + a1[0], bfhi(xi.z) + a1[1]); w.w = pk2(bflo(xi.w) + a1[2], bfhi(xi.w) + a1[3]);
                    *(u32x4*)(Xr + (size_t)(ai * 128 + m * 16) * DM + bj * 128) = w;
                }
    }
};

__device__ __forceinline__ void phase_mod(CPAR& P, unsigned char* lds) {
    float* S = (float*)lds;
    float* Pp = (float*)(lds + 9 * 1024 * 4);
    const int tid = otid(), lane = tid & 63, wave = tid >> 6;
    const float* c = P.in[I_C]; const float* cctx = P.in[I_CCTX];
    for (int i = tid; i < 9 * 1024; i += 512) { const int r = i >> 10, k = i & 1023; const float v = (r == 0) ? cctx[k] : c[(r - 1) * 1024 + k]; S[i] = v / (1.f + __expf(-v)); }
    __syncthreads();
    float* mod = (float*)(P.ws + WS_MOD);
    for (int item = obx(); item < NL * 96; item += ogx()) {
        const int l = item / 96, j0 = (item % 96) * 64;
        const float* w = P.in[I_WADA] + (size_t)l * 1024 * 6144 + j0 + lane;
        float acc[9];
#pragma unroll
        for (int r = 0; r < 9; ++r) acc[r] = 0.f;
        const int k0 = wave * 128;
#pragma unroll 32
        for (int k = k0; k < k0 + 128; ++k) {
            const float wv = w[(size_t)k * 6144];
#pragma unroll
            for (int r = 0; r < 9; ++r) acc[r] = fmaf(S[r * 1024 + k], wv, acc[r]);
        }
#pragma unroll
        for (int r = 0; r < 9; ++r) Pp[(wave * 9 + r) * 64 + lane] = acc[r];
        __syncthreads();
        for (int i = tid; i < 9 * 64; i += 512) {
            const int r = i >> 6, ln = i & 63; float s = 0.f;
#pragma unroll
            for (int w8 = 0; w8 < 8; ++w8) s += Pp[(w8 * 9 + r) * 64 + ln];
            mod[((size_t)l * 9 + r) * 6144 + j0 + ln] = s + P.in[I_BADA][l * 6144 + j0 + ln];
        }
        __syncthreads();
    }
}

__device__ __forceinline__ void transpose_item(const float* W, int K, int N, bf16* WT, int thr, int shift, float* scr, int item, int lane) {
    const int nblk = N / 32, kb = item / nblk, nb = item % nblk, k0 = 64 * kb, n0 = 32 * nb;
    float tv[32];
#pragma unroll
    for (int i = 0; i < 32; ++i) tv[i] = W[(size_t)(k0 + 2 * i + (lane >> 5)) * N + n0 + (lane & 31)];
#pragma unroll
    for (int i = 0; i < 32; ++i) scr[(2 * i + (lane >> 5)) * 33 + (lane & 31)] = tv[i];
    asm volatile("s_waitcnt lgkmcnt(0)" ::: "memory");
    const int c = lane & 7;
    const int r0 = n0 + (n0 >= thr ? shift : 0);
#pragma unroll
    for (int j = 0; j < 4; ++j) { const int n = (lane >> 3) + 8 * j; const float* s = scr + (8 * c) * 33 + n;
        u32x4 o; o.x = pk2(s[0 * 33], s[1 * 33]); o.y = pk2(s[2 * 33], s[3 * 33]); o.z = pk2(s[4 * 33], s[5 * 33]); o.w = pk2(s[6 * 33], s[7 * 33]);
        *(u32x4*)(WT + (size_t)(r0 + n) * K + k0 + 8 * c) = o; }
    asm volatile("s_waitcnt lgkmcnt(0)" ::: "memory");
}
__device__ __forceinline__ void cvt_copy(const float* src, bf16* dst, size_t n4, size_t gt, size_t ngt) {
    for (size_t i = gt; i < n4; i += ngt) { const f32x4 v = *(const f32x4*)(src + 4 * i); u32x2 o; o.x = pk2(v[0], v[1]); o.y = pk2(v[2], v[3]); *(u32x2*)(dst + 4 * i) = o; }
}
__device__ __forceinline__ void phase_conv(CPAR& P, int l, unsigned char* lds, int b0, int nb) {
    const int tid = otid(), lane = tid & 63, wave = tid >> 6;
    float* scr = (float*)(lds + wave * 16384);
    const int gw = (obx() - b0) * 8 + wave, NGW = nb * 8;
    unsigned char* ws = P.ws + (size_t)(l & 1) * WSET;
    constexpr int I0 = 16 * 69, I1 = 16 * 32, I2 = 16 * 128, I3 = 64 * 32, I4 = 4 * 12, I5 = 2 * 16, NIT = I0 + I1 + I2 + I3 + I4 + I5;
    for (int it = gw; it < NIT; it += NGW) {
        int r = it;
        if (r < I0) { transpose_item(P.in[I_WIN] + (size_t)l * 1024 * 2208, 1024, 2208, (bf16*)(ws + WS_WIN), 1696, 96, scr, r, lane); continue; } r -= I0;
        if (r < I1) { transpose_item(P.in[I_WOUT] + (size_t)l * 1024 * 1024, 1024, 1024, (bf16*)(ws + WS_WOUT), 1 << 30, 0, scr, r, lane); continue; } r -= I1;
        if (r < I2) { transpose_item(P.in[I_W1] + (size_t)l * 1024 * 4096, 1024, 4096, (bf16*)(ws + WS_W1), 1 << 30, 0, scr, r, lane); continue; } r -= I2;
        if (r < I3) { transpose_item(P.in[I_W2] + (size_t)l * 4096 * 1024, 4096, 1024, (bf16*)(ws + WS_W2), 1 << 30, 0, scr, r, lane); continue; } r -= I3;
        if (r < I4) { transpose_item(P.in[I_WQUP] + (size_t)l * 256 * 384, 256, 384, (bf16*)(ws + WS_WQ), 1 << 30, 0, scr, r, lane); continue; } r -= I4;
        transpose_item(P.in[I_WKVUP] + (size_t)l * 128 * 512, 128, 512, (bf16*)(ws + WS_WKV), 1 << 30, 0, scr, r, lane);
    }
    const size_t gt = (size_t)(obx() - b0) * 512 + tid, ngt = (size_t)nb * 512;
    { unsigned zz_ = 0u; asm volatile("" : "+v"(zz_)); u32x4 z = {zz_, zz_, zz_, zz_};
      u32x4* p0 = (u32x4*)((bf16*)(ws + WS_WIN) + (size_t)1696 * 1024); for (size_t i = gt; i < 96 * 1024 / 8; i += ngt) p0[i] = z;
      u32x4* p1 = (u32x4*)((bf16*)(ws + WS_WQ) + (size_t)384 * 256); for (size_t i = gt; i < 128 * 256 / 8; i += ngt) p1[i] = z; }
    cvt_copy(P.in[I_SGUW] + (size_t)l * 4 * 128 * 128, (bf16*)(ws + WS_WSGU), 4 * 128 * 128 / 4, gt, ngt);
    for (int b = 0; b < B_LAT; ++b) {
        cvt_copy(P.in[I_CCKV] + ((size_t)(b * NL + l) * PAST) * 128, (bf16*)(P.ws + WS_CKV) + (size_t)(TT + b * PAST) * 128, PAST * 128 / 4, gt, ngt);
        cvt_copy(P.in[I_CKPE] + ((size_t)(b * NL + l) * PAST) * 32, (bf16*)(P.ws + WS_KPE) + (size_t)(TT + b * PAST) * 32, PAST * 32 / 4, gt, ngt);
        cvt_copy(P.in[I_CSK] + ((size_t)(b * NL + l) * PAST) * 128, (bf16*)(P.ws + WS_KSWA) + (size_t)(TT + b * PAST) * 128, PAST * 128 / 4, gt, ngt);
        cvt_copy(P.in[I_CSV] + ((size_t)(b * NL + l) * PAST) * 128, (bf16*)(P.ws + WS_VSWA) + (size_t)(TT + b * PAST) * 128, PAST * 128 / 4, gt, ngt);
    }
}

__device__ __forceinline__ void phase_norm(CPAR& P, int l, int which, bool first, bool addpart) {
    const int tid = otid(), lane = tid & 63, wave = tid >> 6;
    const int gw = obx() * 8 + wave, NGW = ogx() * 8;
    const float* mod = (const float*)(P.ws + WS_MOD) + (size_t)l * 9 * 6144;
    const float* g = P.in[which == 0 ? I_N1 : I_N2] + l * 1024;
    bf16* X = (bf16*)(P.ws + WS_X16); bf16* H = (bf16*)(P.ws + WS_H);
    const int shoff = which == 0 ? 0 : 3 * 1024, scoff = shoff + 1024;
    int cur = -1; f32x4 cg4[4], sh4[4];
    for (int t0 = 4 * gw; t0 < TT; t0 += 4 * NGW) {
        const int idx = mod_idx(t0);
        if (idx != cur) { cur = idx;
#pragma unroll
            for (int j = 0; j < 4; ++j) { const int c0 = 4 * lane + 256 * j; const f32x4 gg = *(const f32x4*)(g + c0), sc = *(const f32x4*)(mod + idx * 6144 + scoff + c0); sh4[j] = *(const f32x4*)(mod + idx * 6144 + shoff + c0); cg4[j] = gg * (sc + 1.f); } }
        f32x4 v[4][4]; float ss[4];
        if (first) {
#pragma unroll
            for (int r = 0; r < 4; ++r) { const int t = t0 + r; const float* xr = t < T_CTX ? P.in[I_XP] + (size_t)t * DM : P.in[I_XS] + (size_t)(t - T_CTX) * DM;
#pragma unroll
                for (int j = 0; j < 4; ++j) v[r][j] = *(const f32x4*)(xr + 4 * lane + 256 * j); }
#pragma unroll
            for (int r = 0; r < 4; ++r)
#pragma unroll
                for (int j = 0; j < 4; ++j) { u32x2 w; w.x = pk2(v[r][j][0], v[r][j][1]); w.y = pk2(v[r][j][2], v[r][j][3]); *(u32x2*)(X + (size_t)(t0 + r) * DM + 4 * lane + 256 * j) = w; }
        } else {
            u32x2 w[4][4];
#pragma unroll
            for (int r = 0; r < 4; ++r)
#pragma unroll
                for (int j = 0; j < 4; ++j) w[r][j] = *(const u32x2*)(X + (size_t)(t0 + r) * DM + 4 * lane + 256 * j);
#pragma unroll
            for (int r = 0; r < 4; ++r)
#pragma unroll
                for (int j = 0; j < 4; ++j) v[r][j] = (f32x4){bflo(w[r][j].x), bfhi(w[r][j].x), bflo(w[r][j].y), bfhi(w[r][j].y)};
            if (addpart && t0 >= SPLIT_ROW0) {
                const bf16* PT = (const bf16*)(P.ws + WS_PART);
#pragma unroll
                for (int r = 0; r < 4; ++r)
#pragma unroll
                    for (int j = 0; j < 4; ++j) w[r][j] = *(const u32x2*)(PT + (size_t)(t0 + r - SPLIT_ROW0) * DM + 4 * lane + 256 * j);
#pragma unroll
                for (int r = 0; r < 4; ++r)
#pragma unroll
                    for (int j = 0; j < 4; ++j) { v[r][j] += (f32x4){bflo(w[r][j].x), bfhi(w[r][j].x), bflo(w[r][j].y), bfhi(w[r][j].y)};
                        u32x2 o; o.x = pk2(v[r][j][0], v[r][j][1]); o.y = pk2(v[r][j][2], v[r][j][3]); *(u32x2*)(X + (size_t)(t0 + r) * DM + 4 * lane + 256 * j) = o;
                        v[r][j] = (f32x4){bflo(o.x), bfhi(o.x), bflo(o.y), bfhi(o.y)}; }
            }
        }
#pragma unroll
        for (int r = 0; r < 4; ++r) { float s = 0.f;
#pragma unroll
            for (int j = 0; j < 4; ++j) s += (v[r][j][0] * v[r][j][0] + v[r][j][1] * v[r][j][1]) + (v[r][j][2] * v[r][j][2] + v[r][j][3] * v[r][j][3]);
            ss[r] = s; }
#pragma unroll
        for (int o = 1; o < 64; o <<= 1) {
#pragma unroll
            for (int r = 0; r < 4; ++r) ss[r] += __shfl_xor(ss[r], o); }
#pragma unroll
        for (int r = 0; r < 4; ++r) { const float rs = rsqrtf(ss[r] * (1.f / DM) + EPSN);
#pragma unroll
            for (int j = 0; j < 4; ++j) {
                const f32x4 o = v[r][j] * rs * cg4[j] + sh4[j];
                u32x2 w; w.x = pk2(o[0], o[1]); w.y = pk2(o[2], o[3]);
                *(u32x2*)(H + (size_t)(t0 + r) * DM + 4 * lane + 256 * j) = w;
            } }
    }
}
__device__ __forceinline__ void phase_final(CPAR& P, bool addpart) {
    const int tid = otid(), lane = tid & 63, wave = tid >> 6;
    const int gw = obx() * 8 + wave, NGW = ogx() * 8;
    const bf16* X = (const bf16*)(P.ws + WS_X16); float* Y = P.out + O_X; const float* g = P.in[I_FN];
    f32x4 g4[4];
#pragma unroll
    for (int j = 0; j < 4; ++j) g4[j] = *(const f32x4*)(g + 4 * lane + 256 * j);
    for (int t = gw; t < TT; t += NGW) {
        f32x4 v[4]; float ss = 0.f;
#pragma unroll
        for (int j = 0; j < 4; ++j) { const u32x2 w = *(const u32x2*)(X + (size_t)t * DM + 4 * lane + 256 * j); v[j] = (f32x4){bflo(w.x), bfhi(w.x), bflo(w.y), bfhi(w.y)};
            if (addpart && t >= SPLIT_ROW0) { const u32x2 q = *(const u32x2*)((const bf16*)(P.ws + WS_PART) + (size_t)(t - SPLIT_ROW0) * DM + 4 * lane + 256 * j); v[j] += (f32x4){bflo(q.x), bfhi(q.x), bflo(q.y), bfhi(q.y)};
                const u32x2 o = {pk2(v[j][0], v[j][1]), pk2(v[j][2], v[j][3])}; v[j] = (f32x4){bflo(o.x), bfhi(o.x), bflo(o.y), bfhi(o.y)}; }
            ss += (v[j][0] * v[j][0] + v[j][1] * v[j][1]) + (v[j][2] * v[j][2] + v[j][3] * v[j][3]); }
        const float rs = rsqrtf(wave_sum(ss) * (1.f / DM) + EPSN);
#pragma unroll
        for (int j = 0; j < 4; ++j) *(f32x4*)(Y + (size_t)t * DM + 4 * lane + 256 * j) = v[j] * rs * g4[j];
    }
}

__device__ __forceinline__ void ld4bf(const bf16* p, float (&v)[4]) { const u32x2 w = *(const u32x2*)p; v[0] = bflo(w.x); v[1] = bfhi(w.x); v[2] = bflo(w.y); v[3] = bfhi(w.y); }
__device__ __forceinline__ void st4bf(bf16* p, const float (&v)[4]) { u32x2 w; w.x = pk2(v[0], v[1]); w.y = pk2(v[2], v[3]); *(u32x2*)p = w; }
__device__ __forceinline__ void cv8(const u32x4 w, float (&v)[8]) { v[0] = bflo(w.x); v[1] = bfhi(w.x); v[2] = bflo(w.y); v[3] = bfhi(w.y); v[4] = bflo(w.z); v[5] = bfhi(w.z); v[6] = bflo(w.w); v[7] = bfhi(w.w); }
__device__ __forceinline__ void st8bf(bf16* p, const float (&v)[8]) { u32x4 w; w.x = pk2(v[0], v[1]); w.y = pk2(v[2], v[3]); w.z = pk2(v[4], v[5]); w.w = pk2(v[6], v[7]); *(u32x4*)p = w; }
__device__ __forceinline__ void phase_mid_rows(CPAR& P, int l) {
    const int tid = otid(), lane = tid & 63, wave = tid >> 6, l32 = lane & 31, half = lane >> 5;
    const int gw = obx() * 8 + wave, NGW = ogx() * 8;
    unsigned char* ws = P.ws;
    const bf16* Z = (const bf16*)(ws + WS_Z);
    bf16* YC = (bf16*)(ws + WS_YCAT); bf16* CQN = (bf16*)(ws + WS_CQN); bf16* CKV = (bf16*)(ws + WS_CKV); bf16* KPE = (bf16*)(ws + WS_KPE);
    bf16* QS = (bf16*)(ws + WS_QSWA); bf16* KS = (bf16*)(ws + WS_KSWA); bf16* VS = (bf16*)(ws + WS_VSWA);
    const int c8 = 8 * l32;
    float cw0[8], cw1[8], cw2[8], qn[8], kvn[8], f64[8], f32r[8];
#pragma unroll
    for (int j = 0; j < 8; ++j) {
        cw0[j] = P.in[I_CONVW][l * 768 + c8 + j]; cw1[j] = P.in[I_CONVW][l * 768 + 256 + c8 + j]; cw2[j] = P.in[I_CONVW][l * 768 + 512 + c8 + j];
        qn[j] = P.in[I_QN][l * 256 + c8 + j]; kvn[j] = P.in[I_KVN][l * 128 + ((c8 + j) & 127)];
        f64[j] = exp2f(-(float)(((c8 & 63) + j) & 15) * (13.287712379549449f / 16.f));
        f32r[j] = exp2f(-(float)j * (13.287712379549449f / 8.f));
    }
    const bool usecol64 = ((c8 & 63) >= 32); const float sgn64 = ((c8 & 63) & 16) ? 1.f : -1.f;
    const bool usecol32 = (l32 & 2) != 0; const float sgn32 = (l32 & 1) ? 1.f : -1.f;
    const u32x4 z4 = {0u, 0u, 0u, 0u};
    u32x4 w_ab = z4, w_ac = z4, w_ax = z4, w_acp = z4, w_axp = z4, w_acn = z4, w_axn = z4, w_cq = z4, w_sq = z4, w_ckv = z4, w_sk = z4, w_sv = z4, w_kpe = z4;
    u32x4 n_ab = z4, n_ac = z4, n_ax = z4, n_acp = z4, n_axp = z4, n_acn = z4, n_axn = z4, n_cq = z4, n_sq = z4, n_ckv = z4, n_sk = z4, n_sv = z4, n_kpe = z4;
#define MR_LOAD(P_, tt_) do { const int t_ = (tt_); const bool lat_ = t_ >= T_CTX; const int S_ = lat_ ? S_LAT : S_CTX, s_ = (lat_ ? t_ - T_CTX : t_) & (S_ - 1); const bf16* zr_ = Z + (size_t)t_ * NZ; \
        P_##ab = *(const u32x4*)(zr_ + ZC_AB + c8); P_##ac = *(const u32x4*)(zr_ + ZC_AC + c8); P_##ax = *(const u32x4*)(zr_ + ZC_AX + c8); \
        P_##acp = z4; P_##axp = z4; P_##acn = z4; P_##axn = z4; P_##ckv = z4; P_##sk = z4; P_##sv = z4; P_##kpe = z4; \
        if (s_ > 0) { P_##acp = *(const u32x4*)(zr_ - NZ + ZC_AC + c8); P_##axp = *(const u32x4*)(zr_ - NZ + ZC_AX + c8); } \
        if (s_ < S_ - 1) { P_##acn = *(const u32x4*)(zr_ + NZ + ZC_AC + c8); P_##axn = *(const u32x4*)(zr_ + NZ + ZC_AX + c8); } \
        P_##cq = *(const u32x4*)(zr_ + ZC_CQ + c8); P_##sq = *(const u32x4*)(zr_ + ZC_SQ + c8); \
        if (l32 < 16) { P_##ckv = *(const u32x4*)(zr_ + ZC_CKV + c8); P_##sk = *(const u32x4*)(zr_ + ZC_SK + c8); P_##sv = *(const u32x4*)(zr_ + ZC_SV + c8); } \
        if (l32 < 4) P_##kpe = *(const u32x4*)(zr_ + ZC_KPE + c8); } while (0)
    if (2 * gw < TT) MR_LOAD(w_, 2 * gw + half);
    for (int t0 = 2 * gw; t0 < TT; t0 += 2 * NGW) {
        const int t = t0 + half;
        const bool lat = t >= T_CTX;
        const int S = lat ? S_LAT : S_CTX, tl = lat ? t - T_CTX : t, b = lat ? tl >> 11 : tl >> 8, s = tl & (S - 1);
        if (t0 + 2 * NGW < TT) MR_LOAD(n_, t + 2 * NGW);
        { float ab[8], ac[8], ax[8], acp[8], axp[8], acn[8], axn[8], y[8];
          cv8(w_ab, ab); cv8(w_ac, ac); cv8(w_ax, ax); cv8(w_acp, acp); cv8(w_axp, axp); cv8(w_acn, acn); cv8(w_axn, axn);
#pragma unroll
          for (int j = 0; j < 8; ++j) y[j] = ab[j] * (cw0[j] * (acp[j] * axp[j]) + cw1[j] * (ac[j] * ax[j]) + cw2[j] * (acn[j] * axn[j]));
          st8bf(YC + (size_t)t * DM + c8, y); }
        { float v[8]; cv8(w_cq, v); float ss = 0.f;
#pragma unroll
          for (int j = 0; j < 8; ++j) ss += v[j] * v[j];
#pragma unroll
          for (int o = 1; o < 32; o <<= 1) ss += __shfl_xor(ss, o);
          const float rs = rsqrtf(ss * (1.f / 256.f) + EPSN);
#pragma unroll
          for (int j = 0; j < 8; ++j) v[j] = v[j] * rs * qn[j];
          st8bf(CQN + (size_t)t * 256 + c8, v); }
        { float v[8]; cv8(w_ckv, v); float ss = 0.f;
#pragma unroll
          for (int j = 0; j < 8; ++j) ss += v[j] * v[j];
#pragma unroll
          for (int o = 1; o < 32; o <<= 1) ss += __shfl_xor(ss, o);
          const float rs = rsqrtf(ss * (1.f / 128.f) + EPSN);
          if (l32 < 16) {
#pragma unroll
              for (int j = 0; j < 8; ++j) v[j] = v[j] * rs * kvn[j];
              st8bf(CKV + (size_t)t * 128 + c8, v);
              if (!lat) { float* oc = P.out + O_CKV + ((size_t)(b * NL + l) * S_CTX + s) * 128 + c8; *(f32x4*)oc = (f32x4){v[0], v[1], v[2], v[3]}; *(f32x4*)(oc + 4) = (f32x4){v[4], v[5], v[6], v[7]}; }
          } }
        const float prow = (float)(s >> 6), pcol = (float)(s & 63);
        { float v[8], o[8]; cv8(w_kpe, v);
#pragma unroll
          for (int j = 0; j < 8; ++j) { const float pv = __shfl_xor(v[j], 1); o[j] = v[j];
              if (lat && l32 < 4) { float sn, cs; sincos_red((usecol32 ? pcol : prow) * f32r[j], sn, cs); o[j] = v[j] * cs + sgn32 * pv * sn; } }
          if (l32 < 4) {
              if (!lat) { float* ok = P.out + O_KPE + ((size_t)(b * NL + l) * S_CTX + s) * 32 + c8; *(f32x4*)ok = (f32x4){v[0], v[1], v[2], v[3]}; *(f32x4*)(ok + 4) = (f32x4){v[4], v[5], v[6], v[7]}; }
              st8bf(KPE + (size_t)t * 32 + c8, o); } }
        { float cs[8], sn[8];
          if (lat) {
#pragma unroll
              for (int j = 0; j < 8; ++j) sincos_red((usecol64 ? pcol : prow) * f64[j], sn[j], cs[j]); }
          float q[8], k[8], vv[8], qo[8], ko[8]; cv8(w_sq, q); cv8(w_sk, k); cv8(w_sv, vv);
#pragma unroll
          for (int j = 0; j < 8; ++j) { const float qp = __shfl_xor(q[j], 2), kp = __shfl_xor(k[j], 2);
              qo[j] = lat ? q[j] * cs[j] + sgn64 * qp * sn[j] : q[j]; ko[j] = lat ? k[j] * cs[j] + sgn64 * kp * sn[j] : k[j]; }
          st8bf(QS + (size_t)t * 256 + c8, qo);
          if (l32 < 16) { st8bf(KS + (size_t)t * 128 + c8, ko); st8bf(VS + (size_t)t * 128 + c8, vv);
              if (!lat) { const size_t oo = ((size_t)(b * NL + l) * S_CTX + s) * 128 + c8;
                  *(f32x4*)(P.out + O_SK + oo) = (f32x4){k[0], k[1], k[2], k[3]}; *(f32x4*)(P.out + O_SK + oo + 4) = (f32x4){k[4], k[5], k[6], k[7]};
                  *(f32x4*)(P.out + O_SV + oo) = (f32x4){vv[0], vv[1], vv[2], vv[3]}; *(f32x4*)(P.out + O_SV + oo + 4) = (f32x4){vv[4], vv[5], vv[6], vv[7]}; } } }
        w_ab = n_ab; w_ac = n_ac; w_ax = n_ax; w_acp = n_acp; w_axp = n_axp; w_acn = n_acn; w_axn = n_axn; w_cq = n_cq; w_sq = n_sq; w_ckv = n_ckv; w_sk = n_sk; w_sv = n_sv; w_kpe = n_kpe;
    }
#undef MR_LOAD
}
__device__ __forceinline__ bf16x8 tr_pair(const LAS unsigned char* p0, const LAS unsigned char* p1) {
    const s16x4 a = __builtin_bit_cast(s16x4, __builtin_amdgcn_ds_read_tr16_b64_v4i16((LAS s16x4*)p0));
    const s16x4 b = __builtin_bit_cast(s16x4, __builtin_amdgcn_ds_read_tr16_b64_v4i16((LAS s16x4*)p1));
    return (bf16x8){a[0], a[1], a[2], a[3], b[0], b[1], b[2], b[3]};
}
constexpr int SG_LD = 272;
__device__ __forceinline__ void phase_mid_sgu(CPAR& P, int l, unsigned char* lds) {
    const int tid = otid(), lane = tid & 63, wave = tid >> 6, r32 = lane & 31, hi = lane >> 5;
    unsigned char* ws = P.ws;
    const bf16* Z = (const bf16*)(ws + WS_Z); bf16* YC = (bf16*)(ws + WS_YCAT); const bf16* WS_ = (const bf16*)(ws + (size_t)(l & 1) * WSET + WS_WSGU);
    bf16* U = (bf16*)lds; bf16* V = (bf16*)(lds + 128 * SG_LD * 2);
    const LAS unsigned char* Vl = (const LAS unsigned char*)(LAS unsigned char*)lds + 128 * SG_LD * 2;
    const int cgp = tid & 31, rr0 = tid >> 5;
    float gn[8];
#pragma unroll
    for (int j = 0; j < 8; ++j) gn[j] = P.in[I_SGUN][l * 256 + cgp * 8 + j];
    for (int chunk = obx(); chunk < TT / 128; chunk += ogx()) {
        const int t0 = chunk * 128;
        u32x4 ura[8], vra[8];
#pragma unroll
        for (int i = 0; i < 8; ++i) { const int row = rr0 + 16 * i; ura[i] = *(const u32x4*)(Z + (size_t)(t0 + row) * NZ + ZC_U + cgp * 8); vra[i] = *(const u32x4*)(Z + (size_t)(t0 + row) * NZ + ZC_V + cgp * 8); }
#pragma unroll
        for (int i = 0; i < 8; ++i) {
            const int row = rr0 + 16 * i;
            const u32x4 ur = ura[i], vr = vra[i];
            float u[8], v[8];
#pragma unroll
            for (int j = 0; j < 4; ++j) { u[2 * j] = gelu_tanh(bflo(ur[j])); u[2 * j + 1] = gelu_tanh(bfhi(ur[j])); v[2 * j] = gelu_tanh(bflo(vr[j])); v[2 * j + 1] = gelu_tanh(bfhi(vr[j])); }
            float ss = 0.f;
#pragma unroll
            for (int j = 0; j < 8; ++j) ss += v[j] * v[j];
#pragma unroll
            for (int o = 1; o < 32; o <<= 1) ss += __shfl_xor(ss, o);
            const float rs = rsqrtf(ss * (1.f / 256.f) + EPSN);
            u32x4 uo, vo;
#pragma unroll
            for (int j = 0; j < 4; ++j) { uo[j] = pk2(u[2 * j], u[2 * j + 1]); vo[j] = pk2(v[2 * j] * rs * gn[2 * j], v[2 * j + 1] * rs * gn[2 * j + 1]); }
            *(u32x4*)(U + row * SG_LD + cgp * 8) = uo; *(u32x4*)(V + row * SG_LD + cgp * 8) = vo;
        }
        __syncthreads();
        const int h = wave >> 1, ph = wave & 1;
        f32x16 acc[2][2];
#pragma unroll
        for (int a = 0; a < 2; ++a)
#pragma unroll
            for (int b2 = 0; b2 < 2; ++b2)
#pragma unroll
                for (int r = 0; r < 16; ++r) acc[a][b2][r] = 0.f;
#pragma unroll 2
        for (int ks = 0; ks < 8; ++ks) {
            const int k0 = 16 * ks;
            bf16x8 af[2], bfr[2];
#pragma unroll
            for (int mi = 0; mi < 2; ++mi) af[mi] = *(const bf16x8*)(WS_ + ((size_t)(h * 128 + ph * 64 + mi * 32 + r32)) * 128 + k0 + 8 * hi);
#pragma unroll
            for (int ni = 0; ni < 2; ++ni) {
                const int rowa = k0 + 8 * hi + ((lane & 15) >> 2), col = h * 64 + ni * 32 + 16 * ((lane >> 4) & 1) + 4 * (lane & 3);
                bfr[ni] = tr_pair(Vl + (rowa * SG_LD + col) * 2, Vl + ((rowa + 4) * SG_LD + col) * 2);
            }
#pragma unroll
            for (int mi = 0; mi < 2; ++mi)
#pragma unroll
                for (int ni = 0; ni < 2; ++ni) acc[mi][ni] = __builtin_amdgcn_mfma_f32_32x32x16_bf16(bfr[ni], af[mi], acc[mi][ni], 0, 0, 0);
        }
        const float* bs = P.in[I_SGUB] + (l * 4 + h) * 128;
#pragma unroll
        for (int mi = 0; mi < 2; ++mi) {
            const int p = ph * 64 + mi * 32 + r32; const float bb = bs[p];
#pragma unroll
            for (int ni = 0; ni < 2; ++ni)
#pragma unroll
                for (int i4 = 0; i4 < 4; ++i4) {
                    const int d = h * 64 + ni * 32 + 8 * i4 + 4 * hi;
                    const u32x2 uw = *(const u32x2*)(U + p * SG_LD + d);
                    u32x2 w; w.x = pk2((acc[mi][ni][4 * i4] + bb) * bflo(uw.x), (acc[mi][ni][4 * i4 + 1] + bb) * bfhi(uw.x));
                    w.y = pk2((acc[mi][ni][4 * i4 + 2] + bb) * bflo(uw.y), (acc[mi][ni][4 * i4 + 3] + bb) * bfhi(uw.y));
                    *(u32x2*)(YC + (size_t)(t0 + p) * DM + 256 + d) = w;
                }
        }
        __syncthreads();
    }
}

constexpr int VLD = 96;
template <bool MLA>
__device__ __forceinline__ void attn_unit(CPAR& P, int l, LAS unsigned char* lds, bool lat, int b, int hh, int qb) {
    constexpr int DK = MLA ? 96 : 64, NS = DK / 16, KLD = MLA ? 104 : 72;
    const int tid = otid(), lane = tid & 63, wave = __builtin_amdgcn_readfirstlane(tid >> 6), r32 = lane & 31, hi = lane >> 5;
    unsigned char* ws = P.ws;
    bf16* YC = (bf16*)(ws + WS_YCAT);
    const int S = lat ? S_LAT : S_CTX;
    const int tokbase = lat ? T_CTX + b * S_LAT : b * S_CTX;
    int qpos, qcol, qstride, g = 0; const bf16* Qp;
    if (MLA) { qpos = qb * 256 + wave * 32 + r32; qcol = hh * 96; Qp = (const bf16*)(ws + WS_QMLA); qstride = 512; }
    else { g = wave >> 2; qpos = qb * 128 + (wave & 3) * 32 + r32; qcol = (hh * 2 + g) * 64; Qp = (const bf16*)(ws + WS_QSWA); qstride = 256; }
    const int tq = tokbase + qpos;
    bf16x8 qf[NS];
#pragma unroll
    for (int s = 0; s < NS; ++s) qf[s] = *(const bf16x8*)(Qp + (size_t)tq * qstride + qcol + 16 * s + 8 * hi);
    if (MLA && lat) {
        const float prow = (float)(qpos >> 6), pcol = (float)(qpos & 63);
        const float sg = hi ? 1.f : -1.f;
#pragma unroll
        for (int s = 4; s < 6; ++s) {
            const float pos = (s == 4) ? prow : pcol;
            u32x4 w = __builtin_bit_cast(u32x4, qf[s]); u32x4 wo;
#pragma unroll
            for (int j = 0; j < 4; ++j) {
                const unsigned pw = (unsigned)__shfl_xor((int)w[j], 32);
                float s0, c0, s1, c1;
                sincos_red(pos * exp2f(-(float)(2 * j) * (13.287712379549449f / 8.f)), s0, c0);
                sincos_red(pos * exp2f(-(float)(2 * j + 1) * (13.287712379549449f / 8.f)), s1, c1);
                const float o0 = bflo(w[j]) * c0 + sg * bflo(pw) * s0, o1 = bfhi(w[j]) * c1 + sg * bfhi(pw) * s1;
                wo[j] = pk2(o0, o1);
            }
            qf[s] = __builtin_bit_cast(bf16x8, wo);
        }
    }
    {
        const float cq = (MLA ? 0.10206207261596577f : 0.125f) * LOG2E;
#pragma unroll
        for (int s = 0; s < NS; ++s) { u32x4 w = __builtin_bit_cast(u32x4, qf[s]);
#pragma unroll
            for (int j = 0; j < 4; ++j) w[j] = pk2(bflo(w[j]) * cq, bfhi(w[j]) * cq);
            qf[s] = __builtin_bit_cast(bf16x8, w); }
    }
    int lo0, n0, n1; bool masked;
    if (MLA) { lo0 = 0; n0 = S / 64; n1 = lat ? PAST / 64 : 0; masked = false; }
    else if (lat) { const int q0 = qb * 128; lo0 = q0 - 128 < 0 ? 0 : q0 - 128; const int hi0 = q0 + 256 > S_LAT ? S_LAT : q0 + 256; n0 = (hi0 - lo0) / 64; n1 = PAST / 64; masked = true; }
    else { lo0 = 0; n0 = S_CTX / 64; n1 = 0; masked = false; }
    const int ntile = n0 + n1, seg1row = TT + b * PAST;
    const bf16* Kmain; const bf16* Vsrc; int kstride;
    if (MLA) { Kmain = (const bf16*)(ws + WS_KVMLA) + hh * 128; Vsrc = Kmain + 64; kstride = 512; }
    else { Kmain = (const bf16*)(ws + WS_KSWA) + hh * 64; Vsrc = (const bf16*)(ws + WS_VSWA) + hh * 64; kstride = 128; }
    const bf16* KPEp = (const bf16*)(ws + WS_KPE);
    const int lrow = tid >> 3, lch = tid & 7, erow = (tid >> 2) & 63, ech = tid & 3;
    constexpr int BUFB = 64 * 104 * 2 + 64 * VLD * 2;
    u32x4 kreg, vreg, ereg = {0u, 0u, 0u, 0u};
#define ATT_LOAD(it_) do { const int it__ = (it_); const int row0 = it__ < n0 ? tokbase + lo0 + it__ * 64 : seg1row + (it__ - n0) * 64; \
        kreg = *(const u32x4*)(Kmain + (size_t)(row0 + lrow) * kstride + lch * 8); vreg = *(const u32x4*)(Vsrc + (size_t)(row0 + lrow) * kstride + lch * 8); \
        if (MLA && tid < 256) ereg = *(const u32x4*)(KPEp + (size_t)(row0 + erow) * 32 + ech * 8); } while (0)
#define ATT_STORE(buf_) do { LAS unsigned char* Kw = lds + (buf_) * BUFB; LAS unsigned char* Vw = Kw + 64 * 104 * 2; \
        *(LAS u32x4*)(Kw + (lrow * KLD + lch * 8) * 2) = kreg; *(LAS u32x4*)(Vw + (lrow * VLD + lch * 8) * 2) = vreg; \
        if (MLA && tid < 256) *(LAS u32x4*)(Kw + (erow * KLD + 64 + ech * 8) * 2) = ereg; } while (0)
    ATT_LOAD(0);
    float mref, lsum;
    if (MLA) { mref = 0.f; lsum = 0.f; } else { const float sk2 = P.in[I_SINK][l * 4 + hh * 2 + g] * LOG2E; mref = bflo(pk2(sk2, 0.f)); lsum = hi ? 0.f : __builtin_amdgcn_exp2f(sk2 - mref); }
    int zi_ = 0; asm volatile("" : "+v"(zi_)); const short z_ = (short)zi_;
    const bf16x8 kx = {hi ? z_ : (short)0x3F80, z_, z_, z_, z_, z_, z_, z_};
    bf16x8 qx = {z_, z_, z_, z_, z_, z_, z_, z_};
    if (!hi) qx[0] = (short)(pk2(-mref, 0.f) & 0xffffu);
    const f32x16 zero16 = {0.f, 0.f, 0.f, 0.f, 0.f, 0.f, 0.f, 0.f, 0.f, 0.f, 0.f, 0.f, 0.f, 0.f, 0.f, 0.f};
    constexpr float THR = 8.f;
    f32x16 o[2];
#pragma unroll
    for (int r = 0; r < 16; ++r) { o[0][r] = 0.f; o[1][r] = 0.f; }
    const int trr = (lane & 15) >> 2, trc = 16 * ((lane >> 4) & 1) + 4 * (lane & 3);
    __syncthreads();
    ATT_STORE(0);
    __syncthreads();
    for (int it = 0; it < ntile; ++it) {
        LAS unsigned char* Kl = lds + (it & 1) * BUFB; LAS unsigned char* Vl = Kl + 64 * 104 * 2;
        if (it + 1 < ntile) ATT_LOAD(it + 1);
        bf16x8 qx2 = qx; asm volatile("" : "+v"(qx2));
        f32x16 p0 = __builtin_amdgcn_mfma_f32_32x32x16_bf16(kx, qx, zero16, 0, 0, 0), p1 = __builtin_amdgcn_mfma_f32_32x32x16_bf16(kx, qx2, zero16, 0, 0, 0);
#pragma unroll
        for (int s = 0; s < NS; ++s) {
            const bf16x8 k0 = *(const LAS bf16x8*)(Kl + (r32 * KLD + 16 * s + 8 * hi) * 2), k1 = *(const LAS bf16x8*)(Kl + ((32 + r32) * KLD + 16 * s + 8 * hi) * 2);
            p0 = __builtin_amdgcn_mfma_f32_32x32x16_bf16(k0, qf[s], p0, 0, 0, 0); p1 = __builtin_amdgcn_mfma_f32_32x32x16_bf16(k1, qf[s], p1, 0, 0, 0);
        }
        if (masked && it < n0) {
            const int dq = qpos - (lo0 + it * 64) - 4 * hi;
#pragma unroll
            for (int r = 0; r < 16; ++r) { const int d0 = dq - ((r & 3) + 8 * (r >> 2)), d1 = d0 - 32;
                if (d0 > 128 || d0 < -128) p0[r] = -INFINITY; if (d1 > 128 || d1 < -128) p1[r] = -INFINITY; }
        }
        float mx;
        { float a = fmaxf(fmaxf(p0[0], p0[1]), p1[0]), b = fmaxf(fmaxf(p0[2], p0[3]), p1[1]); a = fmaxf(fmaxf(a, p1[2]), p1[3]);
#pragma unroll
          for (int r = 4; r < 16; r += 4) { a = fmaxf(fmaxf(a, p0[r]), p0[r + 1]); b = fmaxf(fmaxf(b, p0[r + 2]), p0[r + 3]); a = fmaxf(fmaxf(a, p1[r]), p1[r + 1]); b = fmaxf(fmaxf(b, p1[r + 2]), p1[r + 3]); }
          mx = fmaxf(a, b); }
        mx = fmaxf(mx, __shfl_xor(mx, 32));
        const bool first = MLA && it == 0;
        if (first || __any(mx > THR)) {
            const float mnew = bflo(pk2(mref + (first ? mx : fmaxf(mx, 0.f)), 0.f));
            const float d = mnew - mref;
            mref = mnew;
            if (!hi) qx[0] = (short)(pk2(-mref, 0.f) & 0xffffu);
#pragma unroll
            for (int r = 0; r < 16; ++r) { p0[r] -= d; p1[r] -= d; }
            if (!first) { const float alpha = __builtin_amdgcn_exp2f(-d); lsum *= alpha;
#pragma unroll
                for (int r = 0; r < 16; ++r) { o[0][r] *= alpha; o[1][r] *= alpha; } }
        }
        float ps = 0.f;
#pragma unroll
        for (int r = 0; r < 16; ++r) { p0[r] = __builtin_amdgcn_exp2f(p0[r]); p1[r] = __builtin_amdgcn_exp2f(p1[r]); ps += p0[r] + p1[r]; }
        lsum += ps;
        bf16x8 pa[2][2];
#pragma unroll
        for (int ii = 0; ii < 2; ++ii) {
            u32x4 w0, w1;
#pragma unroll
            for (int j = 0; j < 4; ++j) { w0[j] = pk2(p0[8 * ii + 2 * j], p0[8 * ii + 2 * j + 1]); w1[j] = pk2(p1[8 * ii + 2 * j], p1[8 * ii + 2 * j + 1]); }
            pa[0][ii] = __builtin_bit_cast(bf16x8, w0); pa[1][ii] = __builtin_bit_cast(bf16x8, w1);
        }
        const LAS unsigned char* vb_ = Vl + ((4 * hi + trr) * VLD + trc) * 2;
#pragma unroll
        for (int d0 = 0; d0 < 2; ++d0)
#pragma unroll
            for (int kh = 0; kh < 2; ++kh)
#pragma unroll
                for (int ii = 0; ii < 2; ++ii) {
                    const bf16x8 vf = tr_pair(vb_ + ((32 * kh + 16 * ii) * VLD + 32 * d0) * 2, vb_ + ((32 * kh + 16 * ii + 8) * VLD + 32 * d0) * 2);
                    o[d0] = __builtin_amdgcn_mfma_f32_32x32x16_bf16(vf, pa[kh][ii], o[d0], 0, 0, 0);
                }
        if (it + 1 < ntile) ATT_STORE((it + 1) & 1);
        __syncthreads();
    }
#undef ATT_LOAD
#undef ATT_STORE
    const float ltot = lsum + __shfl_xor(lsum, 32);
    const float inv = 1.f / ltot;
    const int ocol = MLA ? 512 + hh * 64 : 768 + (hh * 2 + g) * 64;
    bf16* op = YC + (size_t)tq * DM + ocol + 4 * hi;
#pragma unroll
    for (int d0 = 0; d0 < 2; ++d0)
#pragma unroll
        for (int i4 = 0; i4 < 4; ++i4) {
            u32x2 w; w.x = pk2(o[d0][4 * i4] * inv, o[d0][4 * i4 + 1] * inv); w.y = pk2(o[d0][4 * i4 + 2] * inv, o[d0][4 * i4 + 3] * inv);
            *(u32x2*)(op + 32 * d0 + 8 * i4) = w;
        }
}
__device__ __forceinline__ void phase_attn(CPAR& P, int l, LAS unsigned char* lds, int vcu) {
    for (int u = vcu; u < 768; u += ogx()) {
        bool mla, lat; int b, hh, qb;
        if (u < 256) { mla = true; lat = true; b = u >> 5; hh = (u >> 3) & 3; qb = u & 7; }
        else if (u < 512) { const int v = u - 256; mla = false; lat = true; b = v >> 5; hh = (v >> 4) & 1; qb = v & 15; }
        else if (u < 640) { const int v = u - 512; mla = true; lat = false; b = v >> 2; hh = v & 3; qb = 0; }
        else { const int v = u - 640; mla = false; lat = false; b = v >> 2; hh = (v >> 1) & 1; qb = v & 1; }
        if (mla) attn_unit<true>(P, l, lds, lat, b, hh, qb); else attn_unit<false>(P, l, lds, lat, b, hh, qb);
    }
    __syncthreads();
}

#define XB_TMO      128
#define XB_XCNT(j)  (256  + 64 * (j))
#define XB_XSUB(j)  (1280 + 64 * (j))
#define XB_XGEN(j)  (2304 + 64 * (j))
#define XB_TOP      3328
#define XB_TOPGEN   3392
#define XCD_BAR_WORDS 3456
#define XB_SPIN_CAP (1u << 18)

__device__ __forceinline__ unsigned xb_ld(unsigned* p)              { return __hip_atomic_load(p, __ATOMIC_RELAXED, __HIP_MEMORY_SCOPE_AGENT); }
__device__ __forceinline__ unsigned xb_add(unsigned* p, unsigned v) { return __hip_atomic_fetch_add(p, v, __ATOMIC_RELAXED, __HIP_MEMORY_SCOPE_AGENT); }
__device__ __forceinline__ unsigned xb_xcc_id() { return (unsigned)__builtin_amdgcn_s_getreg((3 << 11) | 20) & 0xFu; }
#define XB_SPIN(cond, bar) do { unsigned _sp = 0; while (cond) { __builtin_amdgcn_s_sleep(1); \
    if ((++_sp & 255u) == 0u) { if (xb_ld(&(bar)[XB_TMO])) break; if (_sp > XB_SPIN_CAP) { atomicAdd(&(bar)[XB_TMO], 1u); break; } } } } while (0)

struct XcdBarrier {
    unsigned* bar; unsigned x;
    volatile LAS unsigned* st;
};

__device__ __forceinline__ XcdBarrier xcd_barrier_post(unsigned* bar, volatile LAS unsigned* st) {
    XcdBarrier b; b.bar = bar; b.x = xb_xcc_id(); b.st = st;
    if (otid() == 0) (void)xb_add(&bar[XB_XCNT(b.x)], 1u);
    return b;
}
__device__ __forceinline__ void xcd_barrier_complete(unsigned* bar, unsigned x, unsigned& nloc, unsigned& nx) {
    const unsigned G = (unsigned)ogx();
    unsigned sum, cnt, mine, sp = 0u;
    for (;;) {
        sum = 0u; cnt = 0u; mine = 0u;
#pragma unroll
        for (unsigned j = 0; j < 16; ++j) { const unsigned c = xb_ld(&bar[XB_XCNT(j)]); sum += c; cnt += (c > 0u) ? 1u : 0u; mine = (j == x) ? c : mine; }
        if (sum == G) break;
        __builtin_amdgcn_s_sleep(1);
        if ((++sp & 255u) == 0u) { if (xb_ld(&bar[XB_TMO])) break; if (sp > XB_SPIN_CAP) { atomicAdd(&bar[XB_TMO], 1u); break; } }
    }
    nloc = mine > 0u ? mine : 1u; nx = cnt > 0u ? cnt : 1u;
}

__device__ __forceinline__ void xcd_barrier(const XcdBarrier& b) {
    asm volatile("s_waitcnt vmcnt(0)" ::: "memory");
    __syncthreads();
    if (otid() == 0) {
        unsigned* bar = b.bar;
        __builtin_amdgcn_s_waitcnt(0);
        unsigned nloc = b.st[0], nx = b.st[1];
        if (nloc == 0u) { xcd_barrier_complete(bar, b.x, nloc, nx); b.st[0] = nloc; b.st[1] = nx; }
        const unsigned old = xb_add(&bar[XB_XSUB(b.x)], 1u);
        const unsigned gen = old / nloc;
        if (old + 1u == (gen + 1u) * nloc) {
            __builtin_amdgcn_fence(__ATOMIC_RELEASE, "agent");
            asm volatile("s_waitcnt vmcnt(0)" ::: "memory");
            const unsigned og = xb_add(&bar[XB_TOP], 1u);
            const unsigned tg = og / nx;
            if (og + 1u == (tg + 1u) * nx) xb_add(&bar[XB_TOPGEN], 1u);
            else XB_SPIN(xb_ld(&bar[XB_TOPGEN]) == tg, bar);
            __builtin_amdgcn_fence(__ATOMIC_ACQUIRE, "agent");
            xb_add(&bar[XB_XGEN(b.x)], 1u);
            asm volatile("s_waitcnt vmcnt(0)" ::: "memory");
        } else {
            XB_SPIN(xb_ld(&bar[XB_XGEN(b.x)]) == gen, bar);
            __builtin_amdgcn_fence(__ATOMIC_ACQUIRE, "agent");
            asm volatile("s_waitcnt vmcnt(0)" ::: "memory");
        }
    }
    __syncthreads();
}

__global__ void __launch_bounds__(512, 2) fwd_kernel(Params Pval) {
    extern __shared__ __attribute__((aligned(16))) unsigned char lds[];
    cg::grid_group grid = cg::this_grid();
    LAS unsigned char* l3 = (LAS unsigned char*)lds;
    volatile LAS unsigned* bst = (volatile LAS unsigned*)(l3 + LDS_BYTES - 64);
    if (otid() == 0) { bst[0] = 0u; bst[1] = 0u; }
    __syncthreads();
    XcdBarrier xbar = xcd_barrier_post((unsigned*)(Pval.ws + WS_BAR), bst);
#ifndef PHMASK
#define PHMASK 0xffff
#endif
#define GETP() CPAR* q_ = (CPAR*)__builtin_amdgcn_kernarg_segment_ptr(); asm volatile("" : "+s"(q_)); CPAR& P = *q_; unsigned char* ws = P.ws; const int G = ogx(), bx = obx(); (void)ws; (void)G; (void)bx;
#ifndef DBLMASK
#define DBLMASK 0
#endif
#ifndef DBLSYNC
#define DBLSYNC 0
#endif
#define RUN(id, ...) do { CPAR* qq_ = (CPAR*)__builtin_amdgcn_kernarg_segment_ptr(); asm volatile("" : "+s"(qq_)); const int lo_ = qq_->ph_lo, hi_ = qq_->ph_hi; \
        if (ph >= lo_ && ph < hi_) { if ((PHMASK >> (id)) & 1) { GETP(); __VA_ARGS__; } if ((DBLMASK >> (id)) & 1) { __syncthreads(); GETP(); __VA_ARGS__; } if (ph + 1 < hi_) { if (ph == 0) grid.sync(); else xcd_barrier(xbar); if (DBLSYNC) xcd_barrier(xbar); } } ++ph; } while (0)
#define RUN_NOSYNC(id, ...) do { CPAR* qq_ = (CPAR*)__builtin_amdgcn_kernarg_segment_ptr(); asm volatile("" : "+s"(qq_)); const int lo_ = qq_->ph_lo, hi_ = qq_->ph_hi; \
        if (ph >= lo_ && ph < hi_) { if ((PHMASK >> (id)) & 1) { GETP(); __VA_ARGS__; } } } while (0)
    int ph = 0;
    RUN(0, phase_mod(P, lds); phase_conv(P, 0, lds, 0, G));
#pragma unroll 1
    for (int l = 0; l < NL; ++l) {
        RUN(1, phase_norm(P, l, 0, l == 0, l > 0 && G == 256));
        RUN(2, { int kq_ = 1024; asm volatile("" : "+s"(kq_)); pg8::Gemm g{(const bf16*)(ws + WS_H), (const bf16*)(ws + (size_t)(l & 1) * WSET + WS_WIN), TT, NZ, kq_, 0}; pg8::StaticOrder S; S.init(TT, NZ, G, bx); EpiStore<0> E{(bf16*)(ws + WS_Z), NZ};
              pg8::gemm_phase<EpiStore<0>, pg8::StaticOrder, true, true>(l3, g, S, E); });
        RUN(3, phase_mid_rows(P, l); phase_mid_sgu(P, l, lds));
        RUN_NOSYNC(5, { int kq_ = 128; asm volatile("" : "+s"(kq_)); pg8::Gemm g{(const bf16*)(ws + WS_CKV), (const bf16*)(ws + (size_t)(l & 1) * WSET + WS_WKV), KVROWS, 512, kq_, 0}; pg8::StaticOrder S; S.init(KVROWS, 512, G, bx); EpiStore<0> E{(bf16*)(ws + WS_KVMLA), 512};
                pg8::gemm_phase<EpiStore<0>, pg8::StaticOrder, true, true>(l3, g, S, E); });
        RUN(12, { int kq_ = 256; asm volatile("" : "+s"(kq_)); pg8::Gemm g{(const bf16*)(ws + WS_CQN), (const bf16*)(ws + (size_t)(l & 1) * WSET + WS_WQ), TT, 512, kq_, 0}; pg8::StaticOrder S; S.init(TT, 512, G, (bx + 128) % G); EpiStore<0> E{(bf16*)(ws + WS_QMLA), 512};
                pg8::gemm_phase<EpiStore<0>, pg8::StaticOrder, true, true>(l3, g, S, E); });
        RUN(6, { const int vcu = (G % 8 == 0) ? (bx % 8) * (G / 8) + bx / 8 : bx; phase_attn(P, l, l3, vcu); });
        RUN(7, { const float* modl = (const float*)(ws + WS_MOD) + (size_t)l * 9 * 6144; int kq_ = 1024; asm volatile("" : "+s"(kq_)); pg8::Gemm g{(const bf16*)(ws + WS_YCAT), (const bf16*)(ws + (size_t)(l & 1) * WSET + WS_WOUT), TT, 1024, kq_, 0}; pg8::StaticOrder S; S.init(TT, 1024, G, bx); EpiRes E{(bf16*)(ws + WS_X16), modl + 2 * 1024, (bf16*)(ws + WS_PART)};
              pg8::gemm_phase<EpiRes, pg8::StaticOrder, true, true>(l3, g, S, E);
              if (l + 1 < NL && bx >= G / 2) phase_conv(P, l + 1, lds, G / 2, G - G / 2); });
        RUN(8, phase_norm(P, l, 1, false, false));
        RUN(9, { int kq_ = 1024; asm volatile("" : "+s"(kq_)); pg8::Gemm g{(const bf16*)(ws + WS_H), (const bf16*)(ws + (size_t)(l & 1) * WSET + WS_W1), TT, HID, kq_, 0}; pg8::StaticOrder S; S.init(TT, HID, G, bx); EpiStore<1> E{(bf16*)(ws + WS_HID), HID};
              pg8::gemm_phase<EpiStore<1>, pg8::StaticOrder, true, true>(l3, g, S, E); });
        RUN_NOSYNC(10, { const float* modl = (const float*)(ws + WS_MOD) + (size_t)l * 9 * 6144; EpiRes E{(bf16*)(ws + WS_X16), modl + 5 * 1024, (bf16*)(ws + WS_PART)};
              if (G == 256) { int kq_ = HID; asm volatile("" : "+s"(kq_)); pg8::Gemm g{(const bf16*)(ws + WS_HID), (const bf16*)(ws + (size_t)(l & 1) * WSET + WS_W2), TT, 1024, kq_, 0}; pg8::TailSplitOrder<0> S; S.init(bx);
                  pg8::gemm_phase<EpiRes, pg8::TailSplitOrder<0>, true, true>(l3, g, S, E); }
              else { int kq_ = HID; asm volatile("" : "+s"(kq_)); pg8::Gemm g{(const bf16*)(ws + WS_HID), (const bf16*)(ws + (size_t)(l & 1) * WSET + WS_W2), TT, 1024, kq_, 0}; pg8::StaticOrder S; S.init(TT, 1024, G, bx);
                  pg8::gemm_phase<EpiRes, pg8::StaticOrder, true, true>(l3, g, S, E); } });
        RUN(10, { const float* modl = (const float*)(ws + WS_MOD) + (size_t)l * 9 * 6144; EpiRes E{(bf16*)(ws + WS_X16), modl + 5 * 1024, (bf16*)(ws + WS_PART)};
              if (G == 256) { int kq_ = HID; asm volatile("" : "+s"(kq_)); int ks_ = HID / 2; asm volatile("" : "+s"(ks_)); pg8::Gemm g{(const bf16*)(ws + WS_HID), (const bf16*)(ws + (size_t)(l & 1) * WSET + WS_W2), TT, 1024, kq_, ks_}; pg8::TailSplitOrder<1> S; S.init(bx);
                  pg8::gemm_phase<EpiRes, pg8::TailSplitOrder<1>, true, true>(l3, g, S, E); } });
    }
    RUN(11, phase_final(P, G == 256));
#undef RUN
#undef GETP
}

extern "C" void kernel_launch(void* const* d_in, const int* in_sizes, int n_in, void* d_out, int out_size, void* d_ws, size_t ws_size, hipStream_t stream) {
    static int grid = 0;
    if (grid == 0) {
        if (n_in != 26 || ws_size < WS_END) { fprintf(stderr, "kernel_launch: unexpected n_in %d or ws_size %zu (< %zu)\n", n_in, ws_size, (size_t)WS_END); grid = -1; return; }
        int dev = 0, cus = 0, per_cu = 0;
        (void)hipGetDevice(&dev);
        (void)hipDeviceGetAttribute(&cus, hipDeviceAttributeMultiprocessorCount, dev);
        if (hipFuncSetAttribute((const void*)fwd_kernel, hipFuncAttributeMaxDynamicSharedMemorySize, LDS_BYTES) != hipSuccess) fprintf(stderr, "kernel_launch: hipFuncSetAttribute failed\n");
        if (hipOccupancyMaxActiveBlocksPerMultiprocessor(&per_cu, (const void*)fwd_kernel, 512, LDS_BYTES) != hipSuccess || per_cu < 1) { fprintf(stderr, "kernel_launch: occupancy query gave %d\n", per_cu); per_cu = 1; }
        (void)hipGetLastError();
        grid = cus * 1;
        fprintf(stderr, "kernel_launch: cus %d per_cu %d grid %d ws %zu\n", cus, per_cu, grid, ws_size);
    }
    if (grid < 0) return;
    if (hipMemsetAsync((char*)d_ws + WS_BAR, 0, XCD_BAR_WORDS * 4, stream) != hipSuccess) fprintf(stderr, "kernel_launch: memset failed\n");
    Params p; memset(&p, 0, sizeof(p));
    for (int i = 0; i < 26; ++i) p.in[i] = (const float*)d_in[i];
    p.out = (float*)d_out; p.ws = (unsigned char*)d_ws; p.ph_lo = 0; p.ph_hi = NPHASE;
    void* args[] = {&p};
    hipError_t e = hipLaunchCooperativeKernel((const void*)fwd_kernel, dim3(grid), dim3(512), args, LDS_BYTES, stream);
    if (e != hipSuccess) fprintf(stderr, "cooperative launch failed: %s (grid %d)\n", hipGetErrorString(e), grid);
}
```

```cpp
#include <hip/hip_runtime.h>
#include <hip/hip_cooperative_groups.h>
#include <cstdio>
#include <cstdint>
#include <cstring>
namespace cg = cooperative_groups;
__device__ __forceinline__ int otid() { int t = threadIdx.x; asm volatile("" : "+v"(t)); return t; }
__device__ __forceinline__ int obx() { int t = blockIdx.x; asm volatile("" : "+s"(t)); return t; }
__device__ __forceinline__ int ogx() { int t = gridDim.x; asm volatile("" : "+s"(t)); return t; }
namespace pg8 {
#define PG8_LAS __attribute__((address_space(3)))
typedef unsigned short bf16_t;
typedef short bf16x8 __attribute__((ext_vector_type(8)));
typedef float f32x4 __attribute__((ext_vector_type(4)));
typedef unsigned u32x4 __attribute__((ext_vector_type(4)));
constexpr int BM = 256, BK = 64, HALF = 128, HTB = HALF * BK * 2  , STAGE_BYTES = 8 * HTB, NXCD = 8, WGM = 4;

__host__ __device__ __forceinline__ int lds_byte(int r, int c) { const int st = (r >> 4) * 2 + (c >> 5), rr = r & 15, cc = c & 31, ob = rr * 64 + cc * 2; return st * 1024 + (ob ^ (((ob >> 9) & 1) << 5)); }
__host__ __device__ __forceinline__ void stage_rc(int b, int& R, int& C) { const int st = b / 1024, sb = b % 1024, swz = sb ^ (((sb >> 9) & 1) << 5); R = (st >> 1) * 16 + swz / 64; C = (st & 1) * 32 + (swz % 64) / 2; }
__host__ __device__ __forceinline__ int perm32(int rho) { const int n = rho >> 4, i = rho & 15; return 8 * (i >> 2) + 4 * n + (i & 3); }

struct Unit { int pm, pn, kh; };
struct Gemm { const bf16_t* A; const bf16_t* Bt; int M, N, K, ksub; };

struct StaticOrder {
    int nM, nN, nwg, G, c;
    __host__ __device__ void init(int M, int N, int G_, int c_) { nM = M / BM; nN = N / BM; nwg = nM * nN; G = G_; c = c_; }
    __host__ __device__ bool next(int i, Unit& u) const {
        const long L = (long)i * G + c; if (L >= nwg) return false;
        int wgid = (int)L; { const int q = nwg / NXCD, r = nwg % NXCD, xcd = wgid % NXCD, off = wgid / NXCD; wgid = (xcd < r ? xcd * (q + 1) : r * (q + 1) + (xcd - r) * q) + off; }
        const int nig = WGM * nN, gid = wgid / nig, fm = gid * WGM, gsz = (nM - fm) < WGM ? (nM - fm) : WGM;
        u.pm = fm + ((wgid % nig) % gsz); u.pn = (wgid % nig) / gsz; u.kh = 0; return true;
    }
    __device__ __forceinline__ void a_ready(const Unit&) const {}
    __device__ __forceinline__ void done(const Unit&) const {}
};

template <int ROUND> struct TailSplitOrder {
    int c;
    __host__ __device__ void init(int c_) { c = c_; }
    __host__ __device__ bool next(int i, Unit& u) const {
        if (i != 0) return false;
        const int vc = (c % 8) * 32 + c / 8;
        if (ROUND == 0) { u.pm = vc >> 2; u.pn = vc & 3; u.kh = 0; }
        else { const int un = vc >> 1; u.pm = 64 + (un >> 2); u.pn = un & 3; u.kh = vc & 1; }
        return true;
    }
    __device__ __forceinline__ void a_ready(const Unit&) const {}
    __device__ __forceinline__ void done(const Unit&) const {}
};
__device__ __forceinline__ unsigned cvt_pk_bf16(float lo, float hi) { unsigned r; asm volatile("v_cvt_pk_bf16_f32 %0, %1, %2" : "=v"(r) : "v"(lo), "v"(hi)); return r; }
template <class Epi, class Sched, bool ALIGN_EPI = false, bool SP2 = false>
__device__ __forceinline__ void gemm_phase(PG8_LAS unsigned char* lds, const Gemm g, const Sched& S, const Epi& E) {
    const int tid = otid(), wid = __builtin_amdgcn_readfirstlane(tid >> 6), lane = tid & 63, wr = wid >> 2, wc = wid & 3, fr = lane & 15, fq = lane >> 4;
    const int K = g.K, nt = (g.ksub ? g.ksub : K) / BK; const size_t kpart = (size_t)g.ksub * 2;
    unsigned voffA[2], voffB[2];
#pragma unroll
    for (int i = 0; i < 2; ++i) { int R, C; stage_rc(tid * 16 + i * 8192, R, C); const int Rb = Epi::PERM ? ((R & ~31) + perm32(R & 31)) : R;
        voffA[i] = (unsigned)(R * K + C) * 2u; voffB[i] = (unsigned)(Rb * K + C) * 2u; }
    const size_t kstep = (size_t)(BK * 2);
    const size_t hstep = (size_t)HALF * K * 2;
    const size_t tstep = 2 * hstep;
    const unsigned ldsw = (unsigned)wid * 1024u;
    const int aoff = lds_byte(wr * 64 + fr, fq * 8), boff = lds_byte(wc * 32 + fr, fq * 8);
#define PG8_SA(b, h) (((b) * 2 + (h)) * HTB)
#define PG8_SB(b, h) ((4 + (b) * 2 + (h)) * HTB)
#define PG8_STAGE(bufoff, gbase, voff) do { _Pragma("unroll") for (int _i = 0; _i < 2; ++_i) \
        __builtin_amdgcn_global_load_lds((const unsigned*)((const char*)(gbase) + (voff)[_i]), (PG8_LAS unsigned*)(lds + (bufoff) + ldsw + _i * 8192), 16, 0, 0); } while (0)
#define PG8_LDA(dst, b, h) do { _Pragma("unroll") for (int m = 0; m < 4; ++m) _Pragma("unroll") for (int k = 0; k < 2; ++k) dst[m][k] = *(const PG8_LAS bf16x8*)(lds + PG8_SA(b, h) + aoff + m * 2048 + k * 1024); } while (0)
#define PG8_LDB(dst, b, h) do { _Pragma("unroll") for (int n = 0; n < 2; ++n) _Pragma("unroll") for (int k = 0; k < 2; ++k) dst[n][k] = *(const PG8_LAS bf16x8*)(lds + PG8_SB(b, h) + boff + n * 2048 + k * 1024); } while (0)
#define PG8_MMA(ai, bj, At, Bt) do { __builtin_amdgcn_s_setprio(1); _Pragma("unroll") for (int m = 0; m < 4; ++m) _Pragma("unroll") for (int n = 0; n < 2; ++n) _Pragma("unroll") for (int k = 0; k < 2; ++k) \
        acc[ai][bj][m][n] = __builtin_amdgcn_mfma_f32_16x16x32_bf16(Bt[n][k], At[m][k], acc[ai][bj][m][n], 0, 0, 0); __builtin_amdgcn_s_setprio(0); } while (0)
#define PG8_WAIT_V(n) asm volatile("s_waitcnt vmcnt(" #n ")" ::: "memory")
#define PG8_WAIT_L(n) asm volatile("s_waitcnt lgkmcnt(" #n ")" ::: "memory")
#define PG8_BAR __builtin_amdgcn_s_barrier()
#define PG8_SCHED __builtin_amdgcn_sched_barrier(0)
    Unit cur, nxt; int ui = 0;
    if (!S.next(0, cur)) return;
    f32x4 acc[2][2][4][2];
#pragma unroll
    for (int a = 0; a < 2; ++a)
#pragma unroll
        for (int b = 0; b < 2; ++b)
#pragma unroll
            for (int m = 0; m < 4; ++m)
#pragma unroll
                for (int n = 0; n < 2; ++n) acc[a][b][m][n] = (f32x4){0.f, 0.f, 0.f, 0.f};
    bf16x8 At[4][2], B0[2][2], B1[2][2];
    const char* cA = (const char*)g.A + (size_t)cur.pm * tstep + (size_t)cur.kh * kpart; const char* cB = (const char*)g.Bt + (size_t)cur.pn * tstep + (size_t)cur.kh * kpart;
    S.a_ready(cur);
    if constexpr (SP2) {
        PG8_STAGE(PG8_SB(0, 0), cB, voffB); PG8_STAGE(PG8_SB(0, 1), cB + hstep, voffB); PG8_STAGE(PG8_SA(0, 0), cA, voffA); PG8_STAGE(PG8_SA(0, 1), cA + hstep, voffA);
        if (wr == 1) PG8_BAR;
        PG8_WAIT_V(2); PG8_BAR;
        PG8_STAGE(PG8_SB(1, 0), cB + kstep, voffB); PG8_STAGE(PG8_SA(1, 0), cA + kstep, voffA); PG8_STAGE(PG8_SB(1, 1), cB + hstep + kstep, voffB);
        PG8_WAIT_V(6); PG8_BAR;
    } else {
        PG8_STAGE(PG8_SB(0, 0), cB, voffB); PG8_STAGE(PG8_SA(0, 0), cA, voffA); PG8_STAGE(PG8_SB(0, 1), cB + hstep, voffB); PG8_STAGE(PG8_SA(0, 1), cA + hstep, voffA);
        if (wr == 1) PG8_BAR;
        PG8_WAIT_V(4); PG8_BAR;
        PG8_STAGE(PG8_SB(1, 0), cB + kstep, voffB); PG8_STAGE(PG8_SA(1, 0), cA + kstep, voffA); PG8_STAGE(PG8_SB(1, 1), cB + hstep + kstep, voffB);
        PG8_WAIT_V(6); PG8_BAR;
    }
    for (;;) {
        const bool has_next = S.next(ui + 1, nxt);
        const char* nA = has_next ? (const char*)g.A + (size_t)nxt.pm * tstep + (size_t)nxt.kh * kpart : cA; const char* nB = has_next ? (const char*)g.Bt + (size_t)nxt.pn * tstep + (size_t)nxt.kh * kpart : cB;
        for (int t = 0; t < nt; t += 2) {
            const bool last = (t == nt - 2);
            const char* a1 = cA + (size_t)(t + 1) * kstep;
            const char* a2 = last ? nA : cA + (size_t)(t + 2) * kstep; const char* b2 = last ? nB : cB + (size_t)(t + 2) * kstep;
            const char* a3 = a2 + kstep; const char* b3 = b2 + kstep;
            if (last && has_next) S.a_ready(nxt);
            if constexpr (SP2) {
            PG8_LDB(B0, 0, 0); PG8_LDB(B1, 0, 1); PG8_SCHED; PG8_LDA(At, 0, 0); PG8_STAGE(PG8_SA(1, 1), a1 + hstep, voffA);
            PG8_WAIT_V(8); PG8_WAIT_L(0); PG8_BAR; PG8_MMA(0, 0, At, B0); PG8_MMA(0, 1, At, B1); PG8_BAR; PG8_SCHED;
            PG8_LDA(At, 0, 1); PG8_STAGE(PG8_SB(0, 0), b2, voffB); PG8_STAGE(PG8_SB(0, 1), b2 + hstep, voffB); PG8_STAGE(PG8_SA(0, 0), a2, voffA);
            PG8_WAIT_V(8); PG8_WAIT_L(0); PG8_BAR; PG8_MMA(1, 0, At, B0); PG8_MMA(1, 1, At, B1); PG8_BAR; PG8_SCHED;
            PG8_LDB(B0, 1, 0); PG8_LDB(B1, 1, 1); PG8_SCHED; PG8_LDA(At, 1, 0); PG8_STAGE(PG8_SA(0, 1), a2 + hstep, voffA);
            PG8_WAIT_V(8); PG8_WAIT_L(0); PG8_BAR; PG8_MMA(0, 0, At, B0); PG8_MMA(0, 1, At, B1); PG8_BAR; PG8_SCHED;
            PG8_LDA(At, 1, 1); PG8_STAGE(PG8_SB(1, 0), b3, voffB); PG8_STAGE(PG8_SB(1, 1), b3 + hstep, voffB); PG8_STAGE(PG8_SA(1, 0), a3, voffA);
            PG8_WAIT_V(8); PG8_WAIT_L(0); PG8_BAR; PG8_MMA(1, 0, At, B0); PG8_MMA(1, 1, At, B1); PG8_BAR; PG8_SCHED;
            } else {
            PG8_LDB(B0, 0, 0); PG8_SCHED; PG8_LDA(At, 0, 0); PG8_STAGE(PG8_SA(1, 1), a1 + hstep, voffA);
            PG8_WAIT_L(8); PG8_BAR; PG8_WAIT_L(0); PG8_MMA(0, 0, At, B0); PG8_BAR; PG8_SCHED;
            PG8_LDB(B1, 0, 1); PG8_STAGE(PG8_SB(0, 0), b2, voffB);
            PG8_BAR; PG8_WAIT_L(0); PG8_MMA(0, 1, At, B1); PG8_BAR;
            PG8_LDA(At, 0, 1); PG8_STAGE(PG8_SA(0, 0), a2, voffA);
            PG8_BAR; PG8_WAIT_L(0); PG8_MMA(1, 0, At, B0); PG8_BAR; PG8_SCHED;
            PG8_STAGE(PG8_SB(0, 1), b2 + hstep, voffB);
            PG8_WAIT_V(6); PG8_BAR; PG8_MMA(1, 1, At, B1); PG8_BAR;
            PG8_LDB(B0, 1, 0); PG8_SCHED; PG8_LDA(At, 1, 0); PG8_STAGE(PG8_SA(0, 1), a2 + hstep, voffA);
            PG8_WAIT_L(8); PG8_BAR; PG8_WAIT_L(0); PG8_MMA(0, 0, At, B0); PG8_BAR; PG8_SCHED;
            PG8_LDB(B1, 1, 1); PG8_STAGE(PG8_SB(1, 0), b3, voffB);
            PG8_BAR; PG8_WAIT_L(0); PG8_MMA(0, 1, At, B1); PG8_BAR;
            PG8_LDA(At, 1, 1); PG8_STAGE(PG8_SA(1, 0), a3, voffA);
            PG8_BAR; PG8_WAIT_L(0); PG8_MMA(1, 0, At, B0); PG8_BAR; PG8_SCHED;
            PG8_STAGE(PG8_SB(1, 1), b3 + hstep, voffB);
            PG8_WAIT_V(6); PG8_BAR; PG8_MMA(1, 1, At, B1); PG8_BAR;
            }
        }
        if constexpr (ALIGN_EPI) { if (wr == 0) PG8_BAR; }
        if constexpr (!Epi::AFTER_DRAIN) { E(acc, cur, wr, wc, fr, fq); S.done(cur); }
        if (!has_next) break;
    #pragma unroll
        for (int a = 0; a < 2; ++a)
#pragma unroll
            for (int b = 0; b < 2; ++b)
#pragma unroll
                for (int m = 0; m < 4; ++m)
#pragma unroll
                    for (int n = 0; n < 2; ++n) acc[a][b][m][n] = (f32x4){0.f, 0.f, 0.f, 0.f};
        cur = nxt; cA = nA; cB = nB; ++ui;
        if constexpr (ALIGN_EPI) { if (wr == 1) PG8_BAR; }
    }
    PG8_WAIT_V(0);
    if constexpr (!ALIGN_EPI) { if (wr == 0) PG8_BAR; }
    PG8_BAR;
    if constexpr (Epi::AFTER_DRAIN) { E.fused(acc, cur, wr, wc, fr, fq, lds, wid, lane); S.done(cur); }
#undef PG8_SA
#undef PG8_SB
#undef PG8_STAGE
#undef PG8_LDA
#undef PG8_LDB
#undef PG8_MMA
#undef PG8_WAIT_V
#undef PG8_WAIT_L
#undef PG8_BAR
#undef PG8_SCHED
}
}

typedef unsigned short bf16;
typedef short bf16x8 __attribute__((ext_vector_type(8)));
typedef float f32x4 __attribute__((ext_vector_type(4)));
typedef float f32x16 __attribute__((ext_vector_type(16)));
typedef unsigned u32x4 __attribute__((ext_vector_type(4)));
typedef unsigned u32x2 __attribute__((ext_vector_type(2)));
typedef short s16x4 __attribute__((ext_vector_type(4)));
#define LAS __attribute__((address_space(3)))

constexpr int DM = 1024, T_CTX = 8192, T_LAT = 16384, TT = T_CTX + T_LAT, NL = 4;
constexpr int S_CTX = 256, S_LAT = 2048, B_CTX = 32, B_LAT = 8, PAST = 512;
constexpr int NZ = 2304, KVROWS = TT + B_LAT * PAST;
constexpr int HID = 4096;
constexpr float EPSN = 1e-6f;
constexpr float LOG2E = 1.4426950408889634f;
constexpr int ZC_AB = 0, ZC_AC = 256, ZC_AX = 512, ZC_U = 768, ZC_V = 1024, ZC_CQ = 1280, ZC_CKV = 1536, ZC_KPE = 1664, ZC_SQ = 1792, ZC_SK = 2048, ZC_SV = 2176;
enum { I_XP = 0, I_XS, I_CCKV, I_CKPE, I_CSK, I_CSV, I_C, I_CCTX, I_WADA, I_BADA, I_N1, I_N2, I_WIN, I_CONVW, I_SGUN, I_SGUW, I_SGUB, I_QN, I_WQUP, I_KVN, I_WKVUP, I_SINK, I_WOUT, I_W1, I_W2, I_FN };
constexpr size_t O_X = 0, O_CKV = (size_t)TT * DM, O_KPE = O_CKV + (size_t)B_CTX * NL * S_CTX * 128, O_SK = O_KPE + (size_t)B_CTX * NL * S_CTX * 32, O_SV = O_SK + (size_t)B_CTX * NL * S_CTX * 128;
constexpr size_t MiB = 1u << 20;
constexpr size_t WS_MOD = 0, WS_BAR = 896 * 1024;
constexpr size_t WSET = 23 * MiB;
constexpr size_t WS_WIN = 1 * MiB, WS_WOUT = WS_WIN + 4608 * 1024, WS_W1 = WS_WOUT + 2 * MiB, WS_W2 = WS_W1 + 8 * MiB, WS_WQ = WS_W2 + 8 * MiB, WS_WKV = WS_WQ + 256 * 1024, WS_WSGU = WS_WKV + 128 * 1024;
static_assert(WS_WSGU + 128 * 1024 <= 1 * MiB + WSET, "weight set size");
constexpr size_t WS_H = 47 * MiB, BIG0 = 95 * MiB;
constexpr size_t WS_Z = BIG0, WS_YCAT = BIG0 + 108 * MiB, WS_QMLA = BIG0 + 156 * MiB, WS_KVMLA = BIG0 + 180 * MiB, WS_CQN = BIG0 + 208 * MiB, WS_CKV = BIG0 + 220 * MiB, WS_KPE = BIG0 + 227 * MiB,
                 WS_QSWA = BIG0 + 229 * MiB, WS_KSWA = BIG0 + 241 * MiB, WS_VSWA = BIG0 + 248 * MiB, WS_HID = BIG0, WS_X16 = BIG0 + 255 * MiB, WS_PART = BIG0 + 192 * MiB, WS_END = BIG0 + 303 * MiB;
static_assert(WS_END <= 400 * MiB, "workspace budget");
constexpr int LDS_BYTES = 147456;
constexpr int NPHASE = 38;

struct Params { const float* in[26]; float* out; unsigned char* ws; int ph_lo, ph_hi; };
typedef const __attribute__((address_space(4))) Params CPAR;

__device__ __forceinline__ unsigned pk2(float lo, float hi) { return pg8::cvt_pk_bf16(lo, hi); }
__device__ __forceinline__ float bflo(unsigned w) { return __uint_as_float(w << 16); }
__device__ __forceinline__ float bfhi(unsigned w) { return __uint_as_float(w & 0xffff0000u); }
__device__ __forceinline__ float wave_sum(float v) {
#pragma unroll
    for (int o = 1; o < 64; o <<= 1) v += __shfl_xor(v, o);
    return v;
}
__device__ __forceinline__ int crow(int r, int hi) { return (r & 3) + 8 * (r >> 2) + 4 * hi; }
__device__ __forceinline__ int mod_idx(int t) { return t < T_CTX ? 0 : 1 + ((t - T_CTX) >> 11); }
__device__ __forceinline__ float gelu_tanh(float x) {
    const float y = 0.7978845608028654f * (x + 0.044715f * x * x * x);
    const float e = __expf(2.f * y);
    const float th = 1.f - 2.f / (e + 1.f);
    return 0.5f * x * (1.f + th);
}
__device__ __forceinline__ void sincos_red(float a, float& s, float& c) {
    const float k = rintf(a * 0.15915494309189535f);
    float r = fmaf(-k, 6.28318548202514648f, a);
    r = fmaf(-k, -1.7484555e-7f, r);
    s = __sinf(r); c = __cosf(r);
}

template <int ACT> struct EpiStore {
    static constexpr bool PERM = true, AFTER_DRAIN = false;
    bf16* O; int ldc;
    __device__ __forceinline__ void operator()(const f32x4 (&acc)[2][2][4][2], const pg8::Unit& u, int wr, int wc, int fr, int fq) const {
        const int row0 = u.pm * 256 + wr * 64 + fr, col0 = u.pn * 256 + wc * 32 + 8 * fq;
#pragma unroll
        for (int ai = 0; ai < 2; ++ai)
#pragma unroll
            for (int m = 0; m < 4; ++m) {
                bf16* rowp = O + (size_t)(row0 + ai * 128 + m * 16) * ldc + col0;
#pragma unroll
                for (int bj = 0; bj < 2; ++bj) {
                    f32x4 v0 = acc[ai][bj][m][0], v1 = acc[ai][bj][m][1];
                    if (ACT == 1) {
#pragma unroll
                        for (int j = 0; j < 4; ++j) { const float a = fmaxf(v0[j], 0.f), b = fmaxf(v1[j], 0.f); v0[j] = a * a; v1[j] = b * b; }
                    }
                    u32x4 w; w.x = pk2(v0[0], v0[1]); w.y = pk2(v0[2], v0[3]); w.z = pk2(v1[0], v1[1]); w.w = pk2(v1[2], v1[3]);
                    *(u32x4*)(rowp + bj * 128) = w;
                }
            }
    }
};
constexpr int SPLIT_ROW0 = 16384;
struct EpiRes {
    static constexpr bool PERM = true, AFTER_DRAIN = false;
    bf16* X; const float* gate_base; bf16* PART;
    __device__ __forceinline__ void operator()(const f32x4 (&acc)[2][2][4][2], const pg8::Unit& u, int wr, int wc, int fr, int fq) const {
        const int row0 = u.pm * 256 + wr * 64 + fr, col0 = u.pn * 256 + wc * 32 + 8 * fq;
        const float* gate = gate_base + (size_t)mod_idx(u.pm * 256) * 6144 + col0;
        f32x4 gv[2][2];
#pragma unroll
        for (int bj = 0; bj < 2; ++bj)
#pragma unroll
            for (int n = 0; n < 2; ++n) gv[bj][n] = *(const f32x4*)(gate + bj * 128 + 4 * n);
        if (u.kh != 0) {
            bf16* Pr = PART + (size_t)(row0 - SPLIT_ROW0) * DM + col0;
#pragma unroll
            for (int ai = 0; ai < 2; ++ai)
#pragma unroll
                for (int m = 0; m < 4; ++m)
#pragma unroll
                    for (int bj = 0; bj < 2; ++bj) {
                        const f32x4 a0 = acc[ai][bj][m][0] * gv[bj][0], a1 = acc[ai][bj][m][1] * gv[bj][1];
                        u32x4 w; w.x = pk2(a0[0], a0[1]); w.y = pk2(a0[2], a0[3]); w.z = pk2(a1[0], a1[1]); w.w = pk2(a1[2], a1[3]);
                        *(u32x4*)(Pr + (size_t)(ai * 128 + m * 16) * DM + bj * 128) = w;
                    }
            return;
        }
        bf16* Xr = X + (size_t)row0 * DM + col0;
        u32x4 xin[2][4][2];
#pragma unroll
        for (int ai = 0; ai < 2; ++ai)
#pragma unroll
            for (int m = 0; m < 4; ++m)
#pragma unroll
                for (int bj = 0; bj < 2; ++bj) xin[ai][m][bj] = *(const u32x4*)(Xr + (size_t)(ai * 128 + m * 16) * DM + bj * 128);
#pragma unroll
        for (int ai = 0; ai < 2; ++ai)
#pragma unroll
            for (int m = 0; m < 4; ++m)
#pragma unroll
                for (int bj = 0; bj < 2; ++bj) {
                    const u32x4 xi = xin[ai][m][bj];
                    const f32x4 a0 = acc[ai][bj][m][0] * gv[bj][0], a1 = acc[ai][bj][m][1] * gv[bj][1];
                    u32x4 w;
                    w.x = pk2(bflo(xi.x) + a0[0], bfhi(xi.x) + a0[1]); w.y = pk2(bflo(xi.y) + a0[2], bfhi(xi.y) + a0[3]);
                    w.z = pk2(bflo(xi.z) + a1[0], bfhi(xi.z) + a1[1]); w.w = pk2(bflo(xi.w) + a1[2], bfhi(xi.w) + a1[3]);
                    *(u32x4*)(Xr + (size_t)(ai * 128 + m * 16) * DM + bj * 128) = w;
                }
    }
};

__device__ __forceinline__ void phase_mod(CPAR& P, unsigned char* lds) {
    float* S = (float*)lds;
    float* Pp = (float*)(lds + 9 * 1024 * 4);
    const int tid = otid(), lane = tid & 63, wave = tid >> 6;
    const float* c = P.in[I_C]; const float* cctx = P.in[I_CCTX];
    for (int i = tid; i < 9 * 1024; i += 512) { const int r = i >> 10, k = i & 1023; const float v = (r == 0) ? cctx[k] : c[(r - 1) * 1024 + k]; S[i] = v / (1.f + __expf(-v)); }
    __syncthreads();
    float* mod = (float*)(P.ws + WS_MOD);
    for (int item = obx(); item < NL * 96; item += ogx()) {
        const int l = item / 96, j0 = (item % 96) * 64;
        const float* w = P.in[I_WADA] + (size_t)l * 1024 * 6144 + j0 + lane;
        float acc[9];
#pragma unroll
        for (int r = 0; r < 9; ++r) acc[r] = 0.f;
        const int k0 = wave * 128;
#pragma unroll 32
        for (int k = k0; k < k0 + 128; ++k) {
            const float wv = w[(size_t)k * 6144];
#pragma unroll
            for (int r = 0; r < 9; ++r) acc[r] = fmaf(S[r * 1024 + k], wv, acc[r]);
        }
#pragma unroll
        for (int r = 0; r < 9; ++r) Pp[(wave * 9 + r) * 64 + lane] = acc[r];
        __syncthreads();
        for (int i = tid; i < 9 * 64; i += 512) {
            const int r = i >> 6, ln = i & 63; float s = 0.f;
#pragma unroll
            for (int w8 = 0; w8 < 8; ++w8) s += Pp[(w8 * 9 + r) * 64 + ln];
            mod[((size_t)l * 9 + r) * 6144 + j0 + ln] = s + P.in[I_BADA][l * 6144 + j0 + ln];
        }
        __syncthreads();
    }
}

__device__ __forceinline__ void transpose_item(const float* W, int K, int N, bf16* WT, int thr, int shift, float* scr, int item, int lane) {
    const int nblk = N / 32, kb = item / nblk, nb = item % nblk, k0 = 64 * kb, n0 = 32 * nb;
    float tv[32];
#pragma unroll
    for (int i = 0; i < 32; ++i) tv[i] = W[(size_t)(k0 + 2 * i + (lane >> 5)) * N + n0 + (lane & 31)];
#pragma unroll
    for (int i = 0; i < 32; ++i) scr[(2 * i + (lane >> 5)) * 33 + (lane & 31)] = tv[i];
    asm volatile("s_waitcnt lgkmcnt(0)" ::: "memory");
    const int c = lane & 7;
    const int r0 = n0 + (n0 >= thr ? shift : 0);
#pragma unroll
    for (int j = 0; j < 4; ++j) { const int n = (lane >> 3) + 8 * j; const float* s = scr + (8 * c) * 33 + n;
        u32x4 o; o.x = pk2(s[0 * 33], s[1 * 33]); o.y = pk2(s[2 * 33], s[3 * 33]); o.z = pk2(s[4 * 33], s[5 * 33]); o.w = pk2(s[6 * 33], s[7 * 33]);
        *(u32x4*)(WT + (size_t)(r0 + n) * K + k0 + 8 * c) = o; }
    asm volatile("s_waitcnt lgkmcnt(0)" ::: "memory");
}
__device__ __forceinline__ void cvt_copy(const float* src, bf16* dst, size_t n4, size_t gt, size_t ngt) {
    for (size_t i = gt; i < n4; i += ngt) { const f32x4 v = *(const f32x4*)(src + 4 * i); u32x2 o; o.x = pk2(v[0], v[1]); o.y = pk2(v[2], v[3]); *(u32x2*)(dst + 4 * i) = o; }
}
__device__ __forceinline__ void phase_conv(CPAR& P, int l, unsigned char* lds, int b0, int nb) {
    const int tid = otid(), lane = tid & 63, wave = tid >> 6;
    float* scr = (float*)(lds + wave * 16384);
    const int gw = (obx() - b0) * 8 + wave, NGW = nb * 8;
    unsigned char* ws = P.ws + (size_t)(l & 1) * WSET;
    constexpr int I0 = 16 * 69, I1 = 16 * 32, I2 = 16 * 128, I3 = 64 * 32, I4 = 4 * 12, I5 = 2 * 16, NIT = I0 + I1 + I2 + I3 + I4 + I5;
    for (int it = gw; it < NIT; it += NGW) {
        int r = it;
        if (r < I0) { transpose_item(P.in[I_WIN] + (size_t)l * 1024 * 2208, 1024, 2208, (bf16*)(ws + WS_WIN), 1696, 96, scr, r, lane); continue; } r -= I0;
        if (r < I1) { transpose_item(P.in[I_WOUT] + (size_t)l * 1024 * 1024, 1024, 1024, (bf16*)(ws + WS_WOUT), 1 << 30, 0, scr, r, lane); continue; } r -= I1;
        if (r < I2) { transpose_item(P.in[I_W1] + (size_t)l * 1024 * 4096, 1024, 4096, (bf16*)(ws + WS_W1), 1 << 30, 0, scr, r, lane); continue; } r -= I2;
        if (r < I3) { transpose_item(P.in[I_W2] + (size_t)l * 4096 * 1024, 4096, 1024, (bf16*)(ws + WS_W2), 1 << 30, 0, scr, r, lane); continue; } r -= I3;
        if (r < I4) { transpose_item(P.in[I_WQUP] + (size_t)l * 256 * 384, 256, 384, (bf16*)(ws + WS_WQ), 1 << 30, 0, scr, r, lane); continue; } r -= I4;
        transpose_item(P.in[I_WKVUP] + (size_t)l * 128 * 512, 128, 512, (bf16*)(ws + WS_WKV), 1 << 30, 0, scr, r, lane);
    }
    const size_t gt = (size_t)(obx() - b0) * 512 + tid, ngt = (size_t)nb * 512;
    { unsigned zz_ = 0u; asm volatile("" : "+v"(zz_)); u32x4 z = {zz_, zz_, zz_, zz_};
      u32x4* p0 = (u32x4*)((bf16*)(ws + WS_WIN) + (size_t)1696 * 1024); for (size_t i = gt; i < 96 * 1024 / 8; i += ngt) p0[i] = z;
      u32x4* p1 = (u32x4*)((bf16*)(ws + WS_WQ) + (size_t)384 * 256); for (size_t i = gt; i < 128 * 256 / 8; i += ngt) p1[i] = z; }
    cvt_copy(P.in[I_SGUW] + (size_t)l * 4 * 128 * 128, (bf16*)(ws + WS_WSGU), 4 * 128 * 128 / 4, gt, ngt);
    for (int b = 0; b < B_LAT; ++b) {
        cvt_copy(P.in[I_CCKV] + ((size_t)(b * NL + l) * PAST) * 128, (bf16*)(P.ws + WS_CKV) + (size_t)(TT + b * PAST) * 128, PAST * 128 / 4, gt, ngt);
        cvt_copy(P.in[I_CKPE] + ((size_t)(b * NL + l) * PAST) * 32, (bf16*)(P.ws + WS_KPE) + (size_t)(TT + b * PAST) * 32, PAST * 32 / 4, gt, ngt);
        cvt_copy(P.in[I_CSK] + ((size_t)(b * NL + l) * PAST) * 128, (bf16*)(P.ws + WS_KSWA) + (size_t)(TT + b * PAST) * 128, PAST * 128 / 4, gt, ngt);
        cvt_copy(P.in[I_CSV] + ((size_t)(b * NL + l) * PAST) * 128, (bf16*)(P.ws + WS_VSWA) + (size_t)(TT + b * PAST) * 128, PAST * 128 / 4, gt, ngt);
    }
}

__device__ __forceinline__ void phase_norm(CPAR& P, int l, int which, bool first, bool addpart) {
    const int tid = otid(), lane = tid & 63, wave = tid >> 6;
    const int gw = obx() * 8 + wave, NGW = ogx() * 8;
    const float* mod = (const float*)(P.ws + WS_MOD) + (size_t)l * 9 * 6144;
    const float* g = P.in[which == 0 ? I_N1 : I_N2] + l * 1024;
    bf16* X = (bf16*)(P.ws + WS_X16); bf16* H = (bf16*)(P.ws + WS_H);
    const int shoff = which == 0 ? 0 : 3 * 1024, scoff = shoff + 1024;
    int cur = -1; f32x4 cg4[4], sh4[4];
    for (int t0 = 4 * gw; t0 < TT; t0 += 4 * NGW) {
        const int idx = mod_idx(t0);
        if (idx != cur) { cur = idx;
#pragma unroll
            for (int j = 0; j < 4; ++j) { const int c0 = 4 * lane + 256 * j; const f32x4 gg = *(const f32x4*)(g + c0), sc = *(const f32x4*)(mod + idx * 6144 + scoff + c0); sh4[j] = *(const f32x4*)(mod + idx * 6144 + shoff + c0); cg4[j] = gg * (sc + 1.f); } }
        f32x4 v[4][4]; float ss[4];
        if (first) {
#pragma unroll
            for (int r = 0; r < 4; ++r) { const int t = t0 + r; const float* xr = t < T_CTX ? P.in[I_XP] + (size_t)t * DM : P.in[I_XS] + (size_t)(t - T_CTX) * DM;
#pragma unroll
                for (int j = 0; j < 4; ++j) v[r][j] = *(const f32x4*)(xr + 4 * lane + 256 * j); }
#pragma unroll
            for (int r = 0; r < 4; ++r)
#pragma unroll
                for (int j = 0; j < 4; ++j) { u32x2 w; w.x = pk2(v[r][j][0], v[r][j][1]); w.y = pk2(v[r][j][2], v[r][j][3]); *(u32x2*)(X + (size_t)(t0 + r) * DM + 4 * lane + 256 * j) = w; }
        } else {
            u32x2 w[4][4];
#pragma unroll
            for (int r = 0; r < 4; ++r)
#pragma unroll
                for (int j = 0; j < 4; ++j) w[r][j] = *(const u32x2*)(X + (size_t)(t0 + r) * DM + 4 * lane + 256 * j);
#pragma unroll
            for (int r = 0; r < 4; ++r)
#pragma unroll
                for (int j = 0; j < 4; ++j) v[r][j] = (f32x4){bflo(w[r][j].x), bfhi(w[r][j].x), bflo(w[r][j].y), bfhi(w[r][j].y)};
            if (addpart && t0 >= SPLIT_ROW0) {
                const bf16* PT = (const bf16*)(P.ws + WS_PART);
#pragma unroll
                for (int r = 0; r < 4; ++r)
#pragma unroll
                    for (int j = 0; j < 4; ++j) w[r][j] = *(const u32x2*)(PT + (size_t)(t0 + r - SPLIT_ROW0) * DM + 4 * lane + 256 * j);
#pragma unroll
                for (int r = 0; r < 4; ++r)
#pragma unroll
                    for (int j = 0; j < 4; ++j) { v[r][j] += (f32x4){bflo(w[r][j].x), bfhi(w[r][j].x), bflo(w[r][j].y), bfhi(w[r][j].y)};
                        u32x2 o; o.x = pk2(v[r][j][0], v[r][j][1]); o.y = pk2(v[r][j][2], v[r][j][3]); *(u32x2*)(X + (size_t)(t0 + r) * DM + 4 * lane + 256 * j) = o;
                        v[r][j] = (f32x4){bflo(o.x), bfhi(o.x), bflo(o.y), bfhi(o.y)}; }
            }
        }
#pragma unroll
        for (int r = 0; r < 4; ++r) { float s = 0.f;
#pragma unroll
            for (int j = 0; j < 4; ++j) s += (v[r][j][0] * v[r][j][0] + v[r][j][1] * v[r][j][1]) + (v[r][j][2] * v[r][j][2] + v[r][j][3] * v[r][j][3]);
            ss[r] = s; }
#pragma unroll
        for (int o = 1; o < 64; o <<= 1) {
#pragma unroll
            for (int r = 0; r < 4; ++r) ss[r] += __shfl_xor(ss[r], o); }
#pragma unroll
        for (int r = 0; r < 4; ++r) { const float rs = rsqrtf(ss[r] * (1.f / DM) + EPSN);
#pragma unroll
            for (int j = 0; j < 4; ++j) {
                const f32x4 o = v[r][j] * rs * cg4[j] + sh4[j];
                u32x2 w; w.x = pk2(o[0], o[1]); w.y = pk2(o[2], o[3]);
                *(u32x2*)(H + (size_t)(t0 + r) * DM + 4 * lane + 256 * j) = w;
            } }
    }
}
__device__ __forceinline__ void phase_final(CPAR& P, bool addpart) {
    const int tid = otid(), lane = tid & 63, wave = tid >> 6;
    const int gw = obx() * 8 + wave, NGW = ogx() * 8;
    const bf16* X = (const bf16*)(P.ws + WS_X16); float* Y = P.out + O_X; const float* g = P.in[I_FN];
    f32x4 g4[4];
#pragma unroll
    for (int j = 0; j < 4; ++j) g4[j] = *(const f32x4*)(g + 4 * lane + 256 * j);
    for (int t = gw; t < TT; t += NGW) {
        f32x4 v[4]; float ss = 0.f;
#pragma unroll
        for (int j = 0; j < 4; ++j) { const u32x2 w = *(const u32x2*)(X + (size_t)t * DM + 4 * lane + 256 * j); v[j] = (f32x4){bflo(w.x), bfhi(w.x), bflo(w.y), bfhi(w.y)};
            if (addpart && t >= SPLIT_ROW0) { const u32x2 q = *(const u32x2*)((const bf16*)(P.ws + WS_PART) + (size_t)(t - SPLIT_ROW0) * DM + 4 * lane + 256 * j); v[j] += (f32x4){bflo(q.x), bfhi(q.x), bflo(q.y), bfhi(q.y)};
                const u32x2 o = {pk2(v[j][0], v[j][1]), pk2(v[j][2], v[j][3])}; v[j] = (f32x4){bflo(o.x), bfhi(o.x), bflo(o.y), bfhi(o.y)}; }
            ss += (v[j][0] * v[j][0] + v[j][1] * v[j][1]) + (v[j][2] * v[j][2] + v[j][3] * v[j][3]); }
        const float rs = rsqrtf(wave_sum(ss) * (1.f / DM) + EPSN);
#pragma unroll
        for (int j = 0; j < 4; ++j) *(f32x4*)(Y + (size_t)t * DM + 4 * lane + 256 * j) = v[j] * rs * g4[j];
    }
}

__device__ __forceinline__ void ld4bf(const bf16* p, float (&v)[4]) { const u32x2 w = *(const u32x2*)p; v[0] = bflo(w.x); v[1] = bfhi(w.x); v[2] = bflo(w.y); v[3] = bfhi(w.y); }
__device__ __forceinline__ void st4bf(bf16* p, const float (&v)[4]) { u32x2 w; w.x = pk2(v[0], v[1]); w.y = pk2(v[2], v[3]); *(u32x2*)p = w; }
__device__ __forceinline__ void cv8(const u32x4 w, float (&v)[8]) { v[0] = bflo(w.x); v[1] = bfhi(w.x); v[2] = bflo(w.y); v[3] = bfhi(w.y); v[4] = bflo(w.z); v[5] = bfhi(w.z); v[6] = bflo(w.w); v[7] = bfhi(w.w); }
__device__ __forceinline__ void st8bf(bf16* p, const float (&v)[8]) { u32x4 w; w.x = pk2(v[0], v[1]); w.y = pk2(v[2], v[3]); w.z = pk2(v[4], v[5]); w.w = pk2(v[6], v[7]); *(u32x4*)p = w; }
__device__ __forceinline__ void phase_mid_rows(CPAR& P, int l) {
    const int tid = otid(), lane = tid & 63, wave = tid >> 6, l32 = lane & 31, half = lane >> 5;
    const int gw = obx() * 8 + wave, NGW = ogx() * 8;
    unsigned char* ws = P.ws;
    const bf16* Z = (const bf16*)(ws + WS_Z);
    bf16* YC = (bf16*)(ws + WS_YCAT); bf16* CQN = (bf16*)(ws + WS_CQN); bf16* CKV = (bf16*)(ws + WS_CKV); bf16* KPE = (bf16*)(ws + WS_KPE);
    bf16* QS = (bf16*)(ws + WS_QSWA); bf16* KS = (bf16*)(ws + WS_KSWA); bf16* VS = (bf16*)(ws + WS_VSWA);
    const int c8 = 8 * l32;
    float cw0[8], cw1[8], cw2[8], qn[8], kvn[8], f64[8], f32r[8];
#pragma unroll
    for (int j = 0; j < 8; ++j) {
        cw0[j] = P.in[I_CONVW][l * 768 + c8 + j]; cw1[j] = P.in[I_CONVW][l * 768 + 256 + c8 + j]; cw2[j] = P.in[I_CONVW][l * 768 + 512 + c8 + j];
        qn[j] = P.in[I_QN][l * 256 + c8 + j]; kvn[j] = P.in[I_KVN][l * 128 + ((c8 + j) & 127)];
        f64[j] = exp2f(-(float)(((c8 & 63) + j) & 15) * (13.287712379549449f / 16.f));
        f32r[j] = exp2f(-(float)j * (13.287712379549449f / 8.f));
    }
    const bool usecol64 = ((c8 & 63) >= 32); const float sgn64 = ((c8 & 63) & 16) ? 1.f : -1.f;
    const bool usecol32 = (l32 & 2) != 0; const float sgn32 = (l32 & 1) ? 1.f : -1.f;
    const u32x4 z4 = {0u, 0u, 0u, 0u};
    for (int t0 = 2 * gw; t0 < TT; t0 += 2 * NGW) {
        const int t = t0 + half;
        const bool lat = t >= T_CTX;
        const int S = lat ? S_LAT : S_CTX, tl = lat ? t - T_CTX : t, b = lat ? tl >> 11 : tl >> 8, s = tl & (S - 1);
        const bf16* zr = Z + (size_t)t * NZ;
        const u32x4 w_ab = *(const u32x4*)(zr + ZC_AB + c8), w_ac = *(const u32x4*)(zr + ZC_AC + c8), w_ax = *(const u32x4*)(zr + ZC_AX + c8);
        u32x4 w_acp = z4, w_axp = z4, w_acn = z4, w_axn = z4, w_ckv = z4, w_sk = z4, w_sv = z4, w_kpe = z4;
        if (s > 0) { w_acp = *(const u32x4*)(zr - NZ + ZC_AC + c8); w_axp = *(const u32x4*)(zr - NZ + ZC_AX + c8); }
        if (s < S - 1) { w_acn = *(const u32x4*)(zr + NZ + ZC_AC + c8); w_axn = *(const u32x4*)(zr + NZ + ZC_AX + c8); }
        const u32x4 w_cq = *(const u32x4*)(zr + ZC_CQ + c8), w_sq = *(const u32x4*)(zr + ZC_SQ + c8);
        if (l32 < 16) { w_ckv = *(const u32x4*)(zr + ZC_CKV + c8); w_sk = *(const u32x4*)(zr + ZC_SK + c8); w_sv = *(const u32x4*)(zr + ZC_SV + c8); }
        if (l32 < 4) w_kpe = *(const u32x4*)(zr + ZC_KPE + c8);
        { float ab[8], ac[8], ax[8], acp[8], axp[8], acn[8], axn[8], y[8];
          cv8(w_ab, ab); cv8(w_ac, ac); cv8(w_ax, ax); cv8(w_acp, acp); cv8(w_axp, axp); cv8(w_acn, acn); cv8(w_axn, axn);
#pragma unroll
          for (int j = 0; j < 8; ++j) y[j] = ab[j] * (cw0[j] * (acp[j] * axp[j]) + cw1[j] * (ac[j] * ax[j]) + cw2[j] * (acn[j] * axn[j]));
          st8bf(YC + (size_t)t * DM + c8, y); }
        { float v[8]; cv8(w_cq, v); float ss = 0.f;
#pragma unroll
          for (int j = 0; j < 8; ++j) ss += v[j] * v[j];
#pragma unroll
          for (int o = 1; o < 32; o <<= 1) ss += __shfl_xor(ss, o);
          const float rs = rsqrtf(ss * (1.f / 256.f) + EPSN);
#pragma unroll
          for (int j = 0; j < 8; ++j) v[j] = v[j] * rs * qn[j];
          st8bf(CQN + (size_t)t * 256 + c8, v); }
        { float v[8]; cv8(w_ckv, v); float ss = 0.f;
#pragma unroll
          for (int j = 0; j < 8; ++j) ss += v[j] * v[j];
#pragma unroll
          for (int o = 1; o < 32; o <<= 1) ss += __shfl_xor(ss, o);
          const float rs = rsqrtf(ss * (1.f / 128.f) + EPSN);
          if (l32 < 16) {
#pragma unroll
              for (int j = 0; j < 8; ++j) v[j] = v[j] * rs * kvn[j];
              st8bf(CKV + (size_t)t * 128 + c8, v);
              if (!lat) { float* oc = P.out + O_CKV + ((size_t)(b * NL + l) * S_CTX + s) * 128 + c8; *(f32x4*)oc = (f32x4){v[0], v[1], v[2], v[3]}; *(f32x4*)(oc + 4) = (f32x4){v[4], v[5], v[6], v[7]}; }
          } }
        const float prow = (float)(s >> 6), pcol = (float)(s & 63);
        { float v[8], o[8]; cv8(w_kpe, v);
#pragma unroll
          for (int j = 0; j < 8; ++j) { const float pv = __shfl_xor(v[j], 1); o[j] = v[j];
              if (lat && l32 < 4) { float sn, cs; sincos_red((usecol32 ? pcol : prow) * f32r[j], sn, cs); o[j] = v[j] * cs + sgn32 * pv * sn; } }
          if (l32 < 4) {
              if (!lat) { float* ok = P.out + O_KPE + ((size_t)(b * NL + l) * S_CTX + s) * 32 + c8; *(f32x4*)ok = (f32x4){v[0], v[1], v[2], v[3]}; *(f32x4*)(ok + 4) = (f32x4){v[4], v[5], v[6], v[7]}; }
              st8bf(KPE + (size_t)t * 32 + c8, o); } }
        { float cs[8], sn[8];
          if (lat) {
#pragma unroll
              for (int j = 0; j < 8; ++j) sincos_red((usecol64 ? pcol : prow) * f64[j], sn[j], cs[j]); }
          float q[8], k[8], vv[8], qo[8], ko[8]; cv8(w_sq, q); cv8(w_sk, k); cv8(w_sv, vv);
#pragma unroll
          for (int j = 0; j < 8; ++j) { const float qp = __shfl_xor(q[j], 2), kp = __shfl_xor(k[j], 2);
              qo[j] = lat ? q[j] * cs[j] + sgn64 * qp * sn[j] : q[j]; ko[j] = lat ? k[j] * cs[j] + sgn64 * kp * sn[j] : k[j]; }
          st8bf(QS + (size_t)t * 256 + c8, qo);
          if (l32 < 16) { st8bf(KS + (size_t)t * 128 + c8, ko); st8bf(VS + (size_t)t * 128 + c8, vv);
              if (!lat) { const size_t oo = ((size_t)(b * NL + l) * S_CTX + s) * 128 + c8;
                  *(f32x4*)(P.out + O_SK + oo) = (f32x4){k[0], k[1], k[2], k[3]}; *(f32x4*)(P.out + O_SK + oo + 4) = (f32x4){k[4], k[5], k[6], k[7]};
                  *(f32x4*)(P.out + O_SV + oo) = (f32x4){vv[0], vv[1], vv[2], vv[3]}; *(f32x4*)(P.out + O_SV + oo + 4) = (f32x4){vv[4], vv[5], vv[6], vv[7]}; } } }
    }
}
__device__ __forceinline__ bf16x8 tr_pair(const LAS unsigned char* p0, const LAS unsigned char* p1) {
    const s16x4 a = __builtin_bit_cast(s16x4, __builtin_amdgcn_ds_read_tr16_b64_v4i16((LAS s16x4*)p0));
    const s16x4 b = __builtin_bit_cast(s16x4, __builtin_amdgcn_ds_read_tr16_b64_v4i16((LAS s16x4*)p1));
    return (bf16x8){a[0], a[1], a[2], a[3], b[0], b[1], b[2], b[3]};
}
constexpr int SG_LD = 272;
__device__ __forceinline__ void phase_mid_sgu(CPAR& P, int l, unsigned char* lds) {
    const int tid = otid(), lane = tid & 63, wave = tid >> 6, r32 = lane & 31, hi = lane >> 5;
    unsigned char* ws = P.ws;
    const bf16* Z = (const bf16*)(ws + WS_Z); bf16* YC = (bf16*)(ws + WS_YCAT); const bf16* WS_ = (const bf16*)(ws + (size_t)(l & 1) * WSET + WS_WSGU);
    bf16* U = (bf16*)lds; bf16* V = (bf16*)(lds + 128 * SG_LD * 2);
    const LAS unsigned char* Vl = (const LAS unsigned char*)(LAS unsigned char*)lds + 128 * SG_LD * 2;
    const int cgp = tid & 31, rr0 = tid >> 5;
    float gn[8];
#pragma unroll
    for (int j = 0; j < 8; ++j) gn[j] = P.in[I_SGUN][l * 256 + cgp * 8 + j];
    for (int chunk = obx(); chunk < TT / 128; chunk += ogx()) {
        const int t0 = chunk * 128;
        u32x4 ura[8], vra[8];
#pragma unroll
        for (int i = 0; i < 8; ++i) { const int row = rr0 + 16 * i; ura[i] = *(const u32x4*)(Z + (size_t)(t0 + row) * NZ + ZC_U + cgp * 8); vra[i] = *(const u32x4*)(Z + (size_t)(t0 + row) * NZ + ZC_V + cgp * 8); }
#pragma unroll
        for (int i = 0; i < 8; ++i) {
            const int row = rr0 + 16 * i;
            const u32x4 ur = ura[i], vr = vra[i];
            float u[8], v[8];
#pragma unroll
            for (int j = 0; j < 4; ++j) { u[2 * j] = gelu_tanh(bflo(ur[j])); u[2 * j + 1] = gelu_tanh(bfhi(ur[j])); v[2 * j] = gelu_tanh(bflo(vr[j])); v[2 * j + 1] = gelu_tanh(bfhi(vr[j])); }
            float ss = 0.f;
#pragma unroll
            for (int j = 0; j < 8; ++j) ss += v[j] * v[j];
#pragma unroll
            for (int o = 1; o < 32; o <<= 1) ss += __shfl_xor(ss, o);
            const float rs = rsqrtf(ss * (1.f / 256.f) + EPSN);
            u32x4 uo, vo;
#pragma unroll
            for (int j = 0; j < 4; ++j) { uo[j] = pk2(u[2 * j], u[2 * j + 1]); vo[j] = pk2(v[2 * j] * rs * gn[2 * j], v[2 * j + 1] * rs * gn[2 * j + 1]); }
            *(u32x4*)(U + row * SG_LD + cgp * 8) = uo; *(u32x4*)(V + row * SG_LD + cgp * 8) = vo;
        }
        __syncthreads();
        const int h = wave >> 1, ph = wave & 1;
        f32x16 acc[2][2];
#pragma unroll
        for (int a = 0; a < 2; ++a)
#pragma unroll
            for (int b2 = 0; b2 < 2; ++b2)
#pragma unroll
                for (int r = 0; r < 16; ++r) acc[a][b2][r] = 0.f;
#pragma unroll 2
        for (int ks = 0; ks < 8; ++ks) {
            const int k0 = 16 * ks;
            bf16x8 af[2], bfr[2];
#pragma unroll
            for (int mi = 0; mi < 2; ++mi) af[mi] = *(const bf16x8*)(WS_ + ((size_t)(h * 128 + ph * 64 + mi * 32 + r32)) * 128 + k0 + 8 * hi);
#pragma unroll
            for (int ni = 0; ni < 2; ++ni) {
                const int rowa = k0 + 8 * hi + ((lane & 15) >> 2), col = h * 64 + ni * 32 + 16 * ((lane >> 4) & 1) + 4 * (lane & 3);
                bfr[ni] = tr_pair(Vl + (rowa * SG_LD + col) * 2, Vl + ((rowa + 4) * SG_LD + col) * 2);
            }
#pragma unroll
            for (int mi = 0; mi < 2; ++mi)
#pragma unroll
                for (int ni = 0; ni < 2; ++ni) acc[mi][ni] = __builtin_amdgcn_mfma_f32_32x32x16_bf16(bfr[ni], af[mi], acc[mi][ni], 0, 0, 0);
        }
        const float* bs = P.in[I_SGUB] + (l * 4 + h) * 128;
#pragma unroll
        for (int mi = 0; mi < 2; ++mi) {
            const int p = ph * 64 + mi * 32 + r32; const float bb = bs[p];
#pragma unroll
            for (int ni = 0; ni < 2; ++ni)
#pragma unroll
                for (int i4 = 0; i4 < 4; ++i4) {
                    const int d = h * 64 + ni * 32 + 8 * i4 + 4 * hi;
                    const u32x2 uw = *(const u32x2*)(U + p * SG_LD + d);
                    u32x2 w; w.x = pk2((acc[mi][ni][4 * i4] + bb) * bflo(uw.x), (acc[mi][ni][4 * i4 + 1] + bb) * bfhi(uw.x));
                    w.y = pk2((acc[mi][ni][4 * i4 + 2] + bb) * bflo(uw.y), (acc[mi][ni][4 * i4 + 3] + bb) * bfhi(uw.y));
                    *(u32x2*)(YC + (size_t)(t0 + p) * DM + 256 + d) = w;
                }
        }
        __syncthreads();
    }
}

constexpr int VLD = 96;
template <bool MLA>
__device__ __forceinline__ void attn_unit(CPAR& P, int l, LAS unsigned char* lds, bool lat, int b, int hh, int qb) {
    constexpr int DK = MLA ? 96 : 64, NS = DK / 16, KLD = MLA ? 104 : 72;
    const int tid = otid(), lane = tid & 63, wave = __builtin_amdgcn_readfirstlane(tid >> 6), r32 = lane & 31, hi = lane >> 5;
    unsigned char* ws = P.ws;
    bf16* YC = (bf16*)(ws + WS_YCAT);
    const int S = lat ? S_LAT : S_CTX;
    const int tokbase = lat ? T_CTX + b * S_LAT : b * S_CTX;
    int qpos, qcol, qstride, g = 0; const bf16* Qp;
    if (MLA) { qpos = qb * 256 + wave * 32 + r32; qcol = hh * 96; Qp = (const bf16*)(ws + WS_QMLA); qstride = 512; }
    else { g = wave >> 2; qpos = qb * 128 + (wave & 3) * 32 + r32; qcol = (hh * 2 + g) * 64; Qp = (const bf16*)(ws + WS_QSWA); qstride = 256; }
    const int tq = tokbase + qpos;
    bf16x8 qf[NS];
#pragma unroll
    for (int s = 0; s < NS; ++s) qf[s] = *(const bf16x8*)(Qp + (size_t)tq * qstride + qcol + 16 * s + 8 * hi);
    if (MLA && lat) {
        const float prow = (float)(qpos >> 6), pcol = (float)(qpos & 63);
        const float sg = hi ? 1.f : -1.f;
#pragma unroll
        for (int s = 4; s < 6; ++s) {
            const float pos = (s == 4) ? prow : pcol;
            u32x4 w = __builtin_bit_cast(u32x4, qf[s]); u32x4 wo;
#pragma unroll
            for (int j = 0; j < 4; ++j) {
                const unsigned pw = (unsigned)__shfl_xor((int)w[j], 32);
                float s0, c0, s1, c1;
                sincos_red(pos * exp2f(-(float)(2 * j) * (13.287712379549449f / 8.f)), s0, c0);
                sincos_red(pos * exp2f(-(float)(2 * j + 1) * (13.287712379549449f / 8.f)), s1, c1);
                const float o0 = bflo(w[j]) * c0 + sg * bflo(pw) * s0, o1 = bfhi(w[j]) * c1 + sg * bfhi(pw) * s1;
                wo[j] = pk2(o0, o1);
            }
            qf[s] = __builtin_bit_cast(bf16x8, wo);
        }
    }
    {
        const float cq = (MLA ? 0.10206207261596577f : 0.125f) * LOG2E;
#pragma unroll
        for (int s = 0; s < NS; ++s) { u32x4 w = __builtin_bit_cast(u32x4, qf[s]);
#pragma unroll
            for (int j = 0; j < 4; ++j) w[j] = pk2(bflo(w[j]) * cq, bfhi(w[j]) * cq);
            qf[s] = __builtin_bit_cast(bf16x8, w); }
    }
    int lo0, n0, n1; bool masked;
    if (MLA) { lo0 = 0; n0 = S / 64; n1 = lat ? PAST / 64 : 0; masked = false; }
    else if (lat) { const int q0 = qb * 128; lo0 = q0 - 128 < 0 ? 0 : q0 - 128; const int hi0 = q0 + 256 > S_LAT ? S_LAT : q0 + 256; n0 = (hi0 - lo0) / 64; n1 = PAST / 64; masked = true; }
    else { lo0 = 0; n0 = S_CTX / 64; n1 = 0; masked = false; }
    const int ntile = n0 + n1, seg1row = TT + b * PAST;
    const bf16* Kmain; const bf16* Vsrc; int kstride;
    if (MLA) { Kmain = (const bf16*)(ws + WS_KVMLA) + hh * 128; Vsrc = Kmain + 64; kstride = 512; }
    else { Kmain = (const bf16*)(ws + WS_KSWA) + hh * 64; Vsrc = (const bf16*)(ws + WS_VSWA) + hh * 64; kstride = 128; }
    const bf16* KPEp = (const bf16*)(ws + WS_KPE);
    const int lrow = tid >> 3, lch = tid & 7, erow = (tid >> 2) & 63, ech = tid & 3;
    constexpr int BUFB = 64 * 104 * 2 + 64 * VLD * 2;
    u32x4 kreg, vreg, ereg = {0u, 0u, 0u, 0u};
#define ATT_LOAD(it_) do { const int it__ = (it_); const int row0 = it__ < n0 ? tokbase + lo0 + it__ * 64 : seg1row + (it__ - n0) * 64; \
        kreg = *(const u32x4*)(Kmain + (size_t)(row0 + lrow) * kstride + lch * 8); vreg = *(const u32x4*)(Vsrc + (size_t)(row0 + lrow) * kstride + lch * 8); \
        if (MLA && tid < 256) ereg = *(const u32x4*)(KPEp + (size_t)(row0 + erow) * 32 + ech * 8); } while (0)
#define ATT_STORE(buf_) do { LAS unsigned char* Kw = lds + (buf_) * BUFB; LAS unsigned char* Vw = Kw + 64 * 104 * 2; \
        *(LAS u32x4*)(Kw + (lrow * KLD + lch * 8) * 2) = kreg; *(LAS u32x4*)(Vw + (lrow * VLD + lch * 8) * 2) = vreg; \
        if (MLA && tid < 256) *(LAS u32x4*)(Kw + (erow * KLD + 64 + ech * 8) * 2) = ereg; } while (0)
    ATT_LOAD(0);
    float mref, lsum;
    if (MLA) { mref = 0.f; lsum = 0.f; } else { const float sk2 = P.in[I_SINK][l * 4 + hh * 2 + g] * LOG2E; mref = bflo(pk2(sk2, 0.f)); lsum = hi ? 0.f : __builtin_amdgcn_exp2f(sk2 - mref); }
    int zi_ = 0; asm volatile("" : "+v"(zi_)); const short z_ = (short)zi_;
    const bf16x8 kx = {hi ? z_ : (short)0x3F80, z_, z_, z_, z_, z_, z_, z_};
    bf16x8 qx = {z_, z_, z_, z_, z_, z_, z_, z_};
    if (!hi) qx[0] = (short)(pk2(-mref, 0.f) & 0xffffu);
    const f32x16 zero16 = {0.f, 0.f, 0.f, 0.f, 0.f, 0.f, 0.f, 0.f, 0.f, 0.f, 0.f, 0.f, 0.f, 0.f, 0.f, 0.f};
    constexpr float THR = 8.f;
    f32x16 o[2];
#pragma unroll
    for (int r = 0; r < 16; ++r) { o[0][r] = 0.f; o[1][r] = 0.f; }
    const int trr = (lane & 15) >> 2, trc = 16 * ((lane >> 4) & 1) + 4 * (lane & 3);
    __syncthreads();
    ATT_STORE(0);
    __syncthreads();
    for (int it = 0; it < ntile; ++it) {
        LAS unsigned char* Kl = lds + (it & 1) * BUFB; LAS unsigned char* Vl = Kl + 64 * 104 * 2;
        if (it + 1 < ntile) ATT_LOAD(it + 1);
        bf16x8 qx2 = qx; asm volatile("" : "+v"(qx2));
        f32x16 p0 = __builtin_amdgcn_mfma_f32_32x32x16_bf16(kx, qx, zero16, 0, 0, 0), p1 = __builtin_amdgcn_mfma_f32_32x32x16_bf16(kx, qx2, zero16, 0, 0, 0);
#pragma unroll
        for (int s = 0; s < NS; ++s) {
            const bf16x8 k0 = *(const LAS bf16x8*)(Kl + (r32 * KLD + 16 * s + 8 * hi) * 2), k1 = *(const LAS bf16x8*)(Kl + ((32 + r32) * KLD + 16 * s + 8 * hi) * 2);
            p0 = __builtin_amdgcn_mfma_f32_32x32x16_bf16(k0, qf[s], p0, 0, 0, 0); p1 = __builtin_amdgcn_mfma_f32_32x32x16_bf16(k1, qf[s], p1, 0, 0, 0);
        }
        if (masked && it < n0) {
            const int dq = qpos - (lo0 + it * 64) - 4 * hi;
#pragma unroll
            for (int r = 0; r < 16; ++r) { const int d0 = dq - ((r & 3) + 8 * (r >> 2)), d1 = d0 - 32;
                if (d0 > 128 || d0 < -128) p0[r] = -INFINITY; if (d1 > 128 || d1 < -128) p1[r] = -INFINITY; }
        }
        float mx;
        { float a = fmaxf(fmaxf(p0[0], p0[1]), p1[0]), b = fmaxf(fmaxf(p0[2], p0[3]), p1[1]); a = fmaxf(fmaxf(a, p1[2]), p1[3]);
#pragma unroll
          for (int r = 4; r < 16; r += 4) { a = fmaxf(fmaxf(a, p0[r]), p0[r + 1]); b = fmaxf(fmaxf(b, p0[r + 2]), p0[r + 3]); a = fmaxf(fmaxf(a, p1[r]), p1[r + 1]); b = fmaxf(fmaxf(b, p1[r + 2]), p1[r + 3]); }
          mx = fmaxf(a, b); }
        mx = fmaxf(mx, __shfl_xor(mx, 32));
        const bool first = MLA && it == 0;
        if (first || __any(mx > THR)) {
            const float mnew = bflo(pk2(mref + (first ? mx : fmaxf(mx, 0.f)), 0.f));
            const float d = mnew - mref;
            mref = mnew;
            if (!hi) qx[0] = (short)(pk2(-mref, 0.f) & 0xffffu);
#pragma unroll
            for (int r = 0; r < 16; ++r) { p0[r] -= d; p1[r] -= d; }
            if (!first) { const float alpha = __builtin_amdgcn_exp2f(-d); lsum *= alpha;
#pragma unroll
                for (int r = 0; r < 16; ++r) { o[0][r] *= alpha; o[1][r] *= alpha; } }
        }
        float ps = 0.f;
#pragma unroll
        for (int r = 0; r < 16; ++r) { p0[r] = __builtin_amdgcn_exp2f(p0[r]); p1[r] = __builtin_amdgcn_exp2f(p1[r]); ps += p0[r] + p1[r]; }
        lsum += ps;
        bf16x8 pa[2][2];
#pragma unroll
        for (int ii = 0; ii < 2; ++ii) {
            u32x4 w0, w1;
#pragma unroll
            for (int j = 0; j < 4; ++j) { w0[j] = pk2(p0[8 * ii + 2 * j], p0[8 * ii + 2 * j + 1]); w1[j] = pk2(p1[8 * ii + 2 * j], p1[8 * ii + 2 * j + 1]); }
            pa[0][ii] = __builtin_bit_cast(bf16x8, w0); pa[1][ii] = __builtin_bit_cast(bf16x8, w1);
        }
        const LAS unsigned char* vb_ = Vl + ((4 * hi + trr) * VLD + trc) * 2;
#pragma unroll
        for (int d0 = 0; d0 < 2; ++d0)
#pragma unroll
            for (int kh = 0; kh < 2; ++kh)
#pragma unroll
                for (int ii = 0; ii < 2; ++ii) {
                    const bf16x8 vf = tr_pair(vb_ + ((32 * kh + 16 * ii) * VLD + 32 * d0) * 2, vb_ + ((32 * kh + 16 * ii + 8) * VLD + 32 * d0) * 2);
                    o[d0] = __builtin_amdgcn_mfma_f32_32x32x16_bf16(vf, pa[kh][ii], o[d0], 0, 0, 0);
                }
        if (it + 1 < ntile) ATT_STORE((it + 1) & 1);
        __syncthreads();
    }
#undef ATT_LOAD
#undef ATT_STORE
    const float ltot = lsum + __shfl_xor(lsum, 32);
    const float inv = 1.f / ltot;
    const int ocol = MLA ? 512 + hh * 64 : 768 + (hh * 2 + g) * 64;
    bf16* op = YC + (size_t)tq * DM + ocol + 4 * hi;
#pragma unroll
    for (int d0 = 0; d0 < 2; ++d0)
#pragma unroll
        for (int i4 = 0; i4 < 4; ++i4) {
            u32x2 w; w.x = pk2(o[d0][4 * i4] * inv, o[d0][4 * i4 + 1] * inv); w.y = pk2(o[d0][4 * i4 + 2] * inv, o[d0][4 * i4 + 3] * inv);
            *(u32x2*)(op + 32 * d0 + 8 * i4) = w;
        }
}
__device__ __forceinline__ void phase_attn(CPAR& P, int l, LAS unsigned char* lds, int vcu) {
    for (int u = vcu; u < 768; u += ogx()) {
        bool mla, lat; int b, hh, qb;
        if (u < 256) { mla = true; lat = true; b = u >> 5; hh = (u >> 3) & 3; qb = u & 7; }
        else if (u < 512) { const int v = u - 256; mla = false; lat = true; b = v >> 5; hh = (v >> 4) & 1; qb = v & 15; }
        else if (u < 640) { const int v = u - 512; mla = true; lat = false; b = v >> 2; hh = v & 3; qb = 0; }
        else { const int v = u - 640; mla = false; lat = false; b = v >> 2; hh = (v >> 1) & 1; qb = v & 1; }
        if (mla) attn_unit<true>(P, l, lds, lat, b, hh, qb); else attn_unit<false>(P, l, lds, lat, b, hh, qb);
    }
    __syncthreads();
}

#define XB_TMO      128
#define XB_XCNT(j)  (256  + 64 * (j))
#define XB_XSUB(j)  (1280 + 64 * (j))
#define XB_XGEN(j)  (2304 + 64 * (j))
#define XB_TOP      3328
#define XB_TOPGEN   3392
#define XCD_BAR_WORDS 3456
#define XB_SPIN_CAP (1u << 18)

__device__ __forceinline__ unsigned xb_ld(unsigned* p)              { return __hip_atomic_load(p, __ATOMIC_RELAXED, __HIP_MEMORY_SCOPE_AGENT); }
__device__ __forceinline__ unsigned xb_add(unsigned* p, unsigned v) { return __hip_atomic_fetch_add(p, v, __ATOMIC_RELAXED, __HIP_MEMORY_SCOPE_AGENT); }
__device__ __forceinline__ unsigned xb_xcc_id() { return (unsigned)__builtin_amdgcn_s_getreg((3 << 11) | 20) & 0xFu; }
#define XB_SPIN(cond, bar) do { unsigned _sp = 0; while (cond) { __builtin_amdgcn_s_sleep(1); \
    if ((++_sp & 255u) == 0u) { if (xb_ld(&(bar)[XB_TMO])) break; if (_sp > XB_SPIN_CAP) { atomicAdd(&(bar)[XB_TMO], 1u); break; } } } } while (0)

struct XcdBarrier {
    unsigned* bar; unsigned x;
    volatile LAS unsigned* st;
};

__device__ __forceinline__ XcdBarrier xcd_barrier_post(unsigned* bar, volatile LAS unsigned* st) {
    XcdBarrier b; b.bar = bar; b.x = xb_xcc_id(); b.st = st;
    if (otid() == 0) (void)xb_add(&bar[XB_XCNT(b.x)], 1u);
    return b;
}
__device__ __forceinline__ void xcd_barrier_complete(unsigned* bar, unsigned x, unsigned& nloc, unsigned& nx) {
    const unsigned G = (unsigned)ogx();
    unsigned sum, cnt, mine, sp = 0u;
    for (;;) {
        sum = 0u; cnt = 0u; mine = 0u;
#pragma unroll
        for (unsigned j = 0; j < 16; ++j) { const unsigned c = xb_ld(&bar[XB_XCNT(j)]); sum += c; cnt += (c > 0u) ? 1u : 0u; mine = (j == x) ? c : mine; }
        if (sum == G) break;
        __builtin_amdgcn_s_sleep(1);
        if ((++sp & 255u) == 0u) { if (xb_ld(&bar[XB_TMO])) break; if (sp > XB_SPIN_CAP) { atomicAdd(&bar[XB_TMO], 1u); break; } }
    }
    nloc = mine > 0u ? mine : 1u; nx = cnt > 0u ? cnt : 1u;
}

__device__ __forceinline__ void xcd_barrier(const XcdBarrier& b) {
    asm volatile("s_waitcnt vmcnt(0)" ::: "memory");
    __syncthreads();
    if (otid() == 0) {
        unsigned* bar = b.bar;
        __builtin_amdgcn_s_waitcnt(0);
        unsigned nloc = b.st[0], nx = b.st[1];
        if (nloc == 0u) { xcd_barrier_complete(bar, b.x, nloc, nx); b.st[0] = nloc; b.st[1] = nx; }
        const unsigned old = xb_add(&bar[XB_XSUB(b.x)], 1u);
        const unsigned gen = old / nloc;
        if (old + 1u == (gen + 1u) * nloc) {
            __builtin_amdgcn_fence(__ATOMIC_RELEASE, "agent");
            asm volatile("s_waitcnt vmcnt(0)" ::: "memory");
            const unsigned og = xb_add(&bar[XB_TOP], 1u);
            const unsigned tg = og / nx;
            if (og + 1u == (tg + 1u) * nx) xb_add(&bar[XB_TOPGEN], 1u);
            else XB_SPIN(xb_ld(&bar[XB_TOPGEN]) == tg, bar);
            __builtin_amdgcn_fence(__ATOMIC_ACQUIRE, "agent");
            xb_add(&bar[XB_XGEN(b.x)], 1u);
            asm volatile("s_waitcnt vmcnt(0)" ::: "memory");
        } else {
            XB_SPIN(xb_ld(&bar[XB_XGEN(b.x)]) == gen, bar);
            __builtin_amdgcn_fence(__ATOMIC_ACQUIRE, "agent");
            asm volatile("s_waitcnt vmcnt(0)" ::: "memory");
        }
    }
    __syncthreads();
}

__global__ void __launch_bounds__(512, 2) fwd_kernel(Params Pval) {
    extern __shared__ __attribute__((aligned(16))) unsigned char lds[];
    cg::grid_group grid = cg::this_grid();
    LAS unsigned char* l3 = (LAS unsigned char*)lds;
    volatile LAS unsigned* bst = (volatile LAS unsigned*)(l3 + LDS_BYTES - 64);
    if (otid() == 0) { bst[0] = 0u; bst[1] = 0u; }
    __syncthreads();
    XcdBarrier xbar = xcd_barrier_post((unsigned*)(Pval.ws + WS_BAR), bst);
#ifndef PHMASK
#define PHMASK 0xffff
#endif
#define GETP() CPAR* q_ = (CPAR*)__builtin_amdgcn_kernarg_segment_ptr(); asm volatile("" : "+s"(q_)); CPAR& P = *q_; unsigned char* ws = P.ws; const int G = ogx(), bx = obx(); (void)ws; (void)G; (void)bx;
#ifndef DBLMASK
#define DBLMASK 0
#endif
#ifndef DBLSYNC
#define DBLSYNC 0
#endif
#define RUN(id, ...) do { CPAR* qq_ = (CPAR*)__builtin_amdgcn_kernarg_segment_ptr(); asm volatile("" : "+s"(qq_)); const int lo_ = qq_->ph_lo, hi_ = qq_->ph_hi; \
        if (ph >= lo_ && ph < hi_) { if ((PHMASK >> (id)) & 1) { GETP(); __VA_ARGS__; } if ((DBLMASK >> (id)) & 1) { __syncthreads(); GETP(); __VA_ARGS__; } if (ph + 1 < hi_) { if (ph == 0) grid.sync(); else xcd_barrier(xbar); if (DBLSYNC) xcd_barrier(xbar); } } ++ph; } while (0)
#define RUN_NOSYNC(id, ...) do { CPAR* qq_ = (CPAR*)__builtin_amdgcn_kernarg_segment_ptr(); asm volatile("" : "+s"(qq_)); const int lo_ = qq_->ph_lo, hi_ = qq_->ph_hi; \
        if (ph >= lo_ && ph < hi_) { if ((PHMASK >> (id)) & 1) { GETP(); __VA_ARGS__; } } } while (0)
    int ph = 0;
    RUN(0, phase_mod(P, lds); phase_conv(P, 0, lds, 0, G));
#pragma unroll 1
    for (int l = 0; l < NL; ++l) {
        RUN(1, phase_norm(P, l, 0, l == 0, l > 0 && G == 256));
        RUN(2, { int kq_ = 1024; asm volatile("" : "+s"(kq_)); pg8::Gemm g{(const bf16*)(ws + WS_H), (const bf16*)(ws + (size_t)(l & 1) * WSET + WS_WIN), TT, NZ, kq_, 0}; pg8::StaticOrder S; S.init(TT, NZ, G, bx); EpiStore<0> E{(bf16*)(ws + WS_Z), NZ};
              pg8::gemm_phase<EpiStore<0>, pg8::StaticOrder, true, true>(l3, g, S, E); });
        RUN(3, phase_mid_rows(P, l); phase_mid_sgu(P, l, lds));
        RUN_NOSYNC(5, { int kq_ = 128; asm volatile("" : "+s"(kq_)); pg8::Gemm g{(const bf16*)(ws + WS_CKV), (const bf16*)(ws + (size_t)(l & 1) * WSET + WS_WKV), KVROWS, 512, kq_, 0}; pg8::StaticOrder S; S.init(KVROWS, 512, G, bx); EpiStore<0> E{(bf16*)(ws + WS_KVMLA), 512};
                pg8::gemm_phase<EpiStore<0>, pg8::StaticOrder, true, true>(l3, g, S, E); });
        RUN(12, { int kq_ = 256; asm volatile("" : "+s"(kq_)); pg8::Gemm g{(const bf16*)(ws + WS_CQN), (const bf16*)(ws + (size_t)(l & 1) * WSET + WS_WQ), TT, 512, kq_, 0}; pg8::StaticOrder S; S.init(TT, 512, G, (bx + 128) % G); EpiStore<0> E{(bf16*)(ws + WS_QMLA), 512};
                pg8::gemm_phase<EpiStore<0>, pg8::StaticOrder, true, true>(l3, g, S, E); });
        RUN(6, { const int vcu = (G % 8 == 0) ? (bx % 8) * (G / 8) + bx / 8 : bx; phase_attn(P, l, l3, vcu); });
        RUN(7, { const float* modl = (const float*)(ws + WS_MOD) + (size_t)l * 9 * 6144; int kq_ = 1024; asm volatile("" : "+s"(kq_)); pg8::Gemm g{(const bf16*)(ws + WS_YCAT), (const bf16*)(ws + (size_t)(l & 1) * WSET + WS_WOUT), TT, 1024, kq_, 0}; pg8::StaticOrder S; S.init(TT, 1024, G, bx); EpiRes E{(bf16*)(ws + WS_X16), modl + 2 * 1024, (bf16*)(ws + WS_PART)};
              pg8::gemm_phase<EpiRes, pg8::StaticOrder, true, true>(l3, g, S, E);
              if (l + 1 < NL && bx >= G / 2) phase_conv(P, l + 1, lds, G / 2, G - G / 2); });
        RUN(8, phase_norm(P, l, 1, false, false));
        RUN(9, { int kq_ = 1024; asm volatile("" : "+s"(kq_)); pg8::Gemm g{(const bf16*)(ws + WS_H), (const bf16*)(ws + (size_t)(l & 1) * WSET + WS_W1), TT, HID, kq_, 0}; pg8::StaticOrder S; S.init(TT, HID, G, bx); EpiStore<1> E{(bf16*)(ws + WS_HID), HID};
              pg8::gemm_phase<EpiStore<1>, pg8::StaticOrder, true, true>(l3, g, S, E); });
        RUN_NOSYNC(10, { const float* modl = (const float*)(ws + WS_MOD) + (size_t)l * 9 * 6144; EpiRes E{(bf16*)(ws + WS_X16), modl + 5 * 1024, (bf16*)(ws + WS_PART)};
              if (G == 256) { int kq_ = HID; asm volatile("" : "+s"(kq_)); pg8::Gemm g{(const bf16*)(ws + WS_HID), (const bf16*)(ws + (size_t)(l & 1) * WSET + WS_W2), TT, 1024, kq_, 0}; pg8::TailSplitOrder<0> S; S.init(bx);
                  pg8::gemm_phase<EpiRes, pg8::TailSplitOrder<0>, true, true>(l3, g, S, E); }
              else { int kq_ = HID; asm volatile("" : "+s"(kq_)); pg8::Gemm g{(const bf16*)(ws + WS_HID), (const bf16*)(ws + (size_t)(l & 1) * WSET + WS_W2), TT, 1024, kq_, 0}; pg8::StaticOrder S; S.init(TT, 1024, G, bx);
                  pg8::gemm_phase<EpiRes, pg8::StaticOrder, true, true>(l3, g, S, E); } });
        RUN(10, { const float* modl = (const float*)(ws + WS_MOD) + (size_t)l * 9 * 6144; EpiRes E{(bf16*)(ws + WS_X16), modl + 5 * 1024, (bf16*)(ws + WS_PART)};
              if (G == 256) { int kq_ = HID; asm volatile("" : "+s"(kq_)); int ks_ = HID / 2; asm volatile("" : "+s"(ks_)); pg8::Gemm g{(const bf16*)(ws + WS_HID), (const bf16*)(ws + (size_t)(l & 1) * WSET + WS_W2), TT, 1024, kq_, ks_}; pg8::TailSplitOrder<1> S; S.init(bx);
                  pg8::gemm_phase<EpiRes, pg8::TailSplitOrder<1>, true, true>(l3, g, S, E); } });
    }
    RUN(11, phase_final(P, G == 256));
#undef RUN
#undef GETP
}

extern "C" void kernel_launch(void* const* d_in, const int* in_sizes, int n_in, void* d_out, int out_size, void* d_ws, size_t ws_size, hipStream_t stream) {
    static int grid = 0;
    if (grid == 0) {
        if (n_in != 26 || ws_size < WS_END) { fprintf(stderr, "kernel_launch: unexpected n_in %d or ws_size %zu (< %zu)\n", n_in, ws_size, (size_t)WS_END); grid = -1; return; }
        int dev = 0, cus = 0, per_cu = 0;
        (void)hipGetDevice(&dev);
        (void)hipDeviceGetAttribute(&cus, hipDeviceAttributeMultiprocessorCount, dev);
        if (hipFuncSetAttribute((const void*)fwd_kernel, hipFuncAttributeMaxDynamicSharedMemorySize, LDS_BYTES) != hipSuccess) fprintf(stderr, "kernel_launch: hipFuncSetAttribute failed\n");
        if (hipOccupancyMaxActiveBlocksPerMultiprocessor(&per_cu, (const void*)fwd_kernel, 512, LDS_BYTES) != hipSuccess || per_cu < 1) { fprintf(stderr, "kernel_launch: occupancy query gave %d\n", per_cu); per_cu = 1; }
        (void)hipGetLastError();
        grid = cus * 1;
        fprintf(stderr, "kernel_launch: cus %d per_cu %d grid %d ws %zu\n", cus, per_cu, grid, ws_size);
    }
    if (grid < 0) return;
    if (hipMemsetAsync((char*)d_ws + WS_BAR, 0, XCD_BAR_WORDS * 4, stream) != hipSuccess) fprintf(stderr, "kernel_launch: memset failed\n");
    Params p; memset(&p, 0, sizeof(p));
    for (int i = 0; i < 26; ++i) p.in[i] = (const float*)d_in[i];
    p.out = (float*)d_out; p.ws = (unsigned char*)d_ws; p.ph_lo = 0; p.ph_hi = NPHASE;
    void* args[] = {&p};
    hipError_t e = hipLaunchCooperativeKernel((const void*)fwd_kernel, dim3(grid), dim3(512), args, LDS_BYTES, stream);
    if (e != hipSuccess) fprintf(stderr, "cooperative launch failed: %s (grid %d)\n", hipGetErrorString(e), grid);
}
```

```cpp
#include <hip/hip_runtime.h>
#include <hip/hip_cooperative_groups.h>
#include <cstdio>
#include <cstdint>
#include <cstring>
namespace cg = cooperative_groups;
__device__ __forceinline__ int otid() { int t = threadIdx.x; asm volatile("" : "+v"(t)); return t; }
__device__ __forceinline__ int obx() { int t = blockIdx.x; asm volatile("" : "+s"(t)); return t; }
__device__ __forceinline__ int ogx() { int t = gridDim.x; asm volatile("" : "+s"(t)); return t; }
namespace pg8 {
#define PG8_LAS __attribute__((address_space(3)))
typedef unsigned short bf16_t;
typedef short bf16x8 __attribute__((ext_vector_type(8)));
typedef float f32x4 __attribute__((ext_vector_type(4)));
typedef unsigned u32x4 __attribute__((ext_vector_type(4)));
constexpr int BM = 256, BK = 64, HALF = 128, HTB = HALF * BK * 2  , STAGE_BYTES = 8 * HTB, NXCD = 8, WGM = 8;

__host__ __device__ __forceinline__ int lds_byte(int r, int c) { const int st = (r >> 4) * 2 + (c >> 5), rr = r & 15, cc = c & 31, ob = rr * 64 + cc * 2; return st * 1024 + (ob ^ (((ob >> 9) & 1) << 5)); }
__host__ __device__ __forceinline__ void stage_rc(int b, int& R, int& C) { const int st = b / 1024, sb = b % 1024, swz = sb ^ (((sb >> 9) & 1) << 5); R = (st >> 1) * 16 + swz / 64; C = (st & 1) * 32 + (swz % 64) / 2; }
__host__ __device__ __forceinline__ int perm32(int rho) { const int n = rho >> 4, i = rho & 15; return 8 * (i >> 2) + 4 * n + (i & 3); }

struct Unit { int pm, pn, kh; };
struct Gemm { const bf16_t* A; const bf16_t* Bt; int M, N, K, ksub; };

struct StaticOrder {
    int nM, nN, nwg, G, c;
    __host__ __device__ void init(int M, int N, int G_, int c_) { nM = M / BM; nN = N / BM; nwg = nM * nN; G = G_; c = c_; }
    __host__ __device__ bool next(int i, Unit& u) const {
        const long L = (long)i * G + c; if (L >= nwg) return false;
        int wgid = (int)L; { const int q = nwg / NXCD, r = nwg % NXCD, xcd = wgid % NXCD, off = wgid / NXCD; wgid = (xcd < r ? xcd * (q + 1) : r * (q + 1) + (xcd - r) * q) + off; }
        const int nig = WGM * nN, gid = wgid / nig, fm = gid * WGM, gsz = (nM - fm) < WGM ? (nM - fm) : WGM;
        u.pm = fm + ((wgid % nig) % gsz); u.pn = (wgid % nig) / gsz; u.kh = 0; return true;
    }
    __device__ __forceinline__ void a_ready(const Unit&) const {}
    __device__ __forceinline__ void done(const Unit&) const {}
};

template <int ROUND> struct TailSplitOrder {
    int c;
    __host__ __device__ void init(int c_) { c = c_; }
    __host__ __device__ bool next(int i, Unit& u) const {
        if (i != 0) return false;
        const int vc = (c % 8) * 32 + c / 8;
        if (ROUND == 0) { u.pm = vc >> 2; u.pn = vc & 3; u.kh = 0; }
        else { const int un = vc >> 1; u.pm = 64 + (un >> 2); u.pn = un & 3; u.kh = vc & 1; }
        return true;
    }
    __device__ __forceinline__ void a_ready(const Unit&) const {}
    __device__ __forceinline__ void done(const Unit&) const {}
};
__device__ __forceinline__ unsigned cvt_pk_bf16(float lo, float hi) { unsigned r; asm volatile("v_cvt_pk_bf16_f32 %0, %1, %2" : "=v"(r) : "v"(lo), "v"(hi)); return r; }
template <class Epi, class Sched, bool ALIGN_EPI = false, bool SP2 = false>
__device__ __forceinline__ void gemm_phase(PG8_LAS unsigned char* lds, const Gemm g, const Sched& S, const Epi& E) {
    const int tid = otid(), wid = __builtin_amdgcn_readfirstlane(tid >> 6), lane = tid & 63, wr = wid >> 2, wc = wid & 3, fr = lane & 15, fq = lane >> 4;
    const int K = g.K, nt = (g.ksub ? g.ksub : K) / BK; const size_t kpart = (size_t)g.ksub * 2;
    unsigned voffA[2], voffB[2];
#pragma unroll
    for (int i = 0; i < 2; ++i) { int R, C; stage_rc(tid * 16 + i * 8192, R, C); const int Rb = Epi::PERM ? ((R & ~31) + perm32(R & 31)) : R;
        voffA[i] = (unsigned)(R * K + C) * 2u; voffB[i] = (unsigned)(Rb * K + C) * 2u; }
    const size_t kstep = (size_t)(BK * 2);
    const size_t hstep = (size_t)HALF * K * 2;
    const size_t tstep = 2 * hstep;
    const unsigned ldsw = (unsigned)wid * 1024u;
    const int aoff = lds_byte(wr * 64 + fr, fq * 8), boff = lds_byte(wc * 32 + fr, fq * 8);
#define PG8_SA(b, h) (((b) * 2 + (h)) * HTB)
#define PG8_SB(b, h) ((4 + (b) * 2 + (h)) * HTB)
#define PG8_STAGE(bufoff, gbase, voff) do { _Pragma("unroll") for (int _i = 0; _i < 2; ++_i) \
        __builtin_amdgcn_global_load_lds((const unsigned*)((const char*)(gbase) + (voff)[_i]), (PG8_LAS unsigned*)(lds + (bufoff) + ldsw + _i * 8192), 16, 0, 0); } while (0)
#define PG8_LDA(dst, b, h) do { _Pragma("unroll") for (int m = 0; m < 4; ++m) _Pragma("unroll") for (int k = 0; k < 2; ++k) dst[m][k] = *(const PG8_LAS bf16x8*)(lds + PG8_SA(b, h) + aoff + m * 2048 + k * 1024); } while (0)
#define PG8_LDB(dst, b, h) do { _Pragma("unroll") for (int n = 0; n < 2; ++n) _Pragma("unroll") for (int k = 0; k < 2; ++k) dst[n][k] = *(const PG8_LAS bf16x8*)(lds + PG8_SB(b, h) + boff + n * 2048 + k * 1024); } while (0)
#define PG8_MMA(ai, bj, At, Bt) do { __builtin_amdgcn_s_setprio(1); _Pragma("unroll") for (int m = 0; m < 4; ++m) _Pragma("unroll") for (int n = 0; n < 2; ++n) _Pragma("unroll") for (int k = 0; k < 2; ++k) \
        acc[ai][bj][m][n] = __builtin_amdgcn_mfma_f32_16x16x32_bf16(Bt[n][k], At[m][k], acc[ai][bj][m][n], 0, 0, 0); __builtin_amdgcn_s_setprio(0); } while (0)
#define PG8_WAIT_V(n) asm volatile("s_waitcnt vmcnt(" #n ")" ::: "memory")
#define PG8_WAIT_L(n) asm volatile("s_waitcnt lgkmcnt(" #n ")" ::: "memory")
#define PG8_BAR __builtin_amdgcn_s_barrier()
#define PG8_SCHED __builtin_amdgcn_sched_barrier(0)
    Unit cur, nxt; int ui = 0;
    if (!S.next(0, cur)) return;
    f32x4 acc[2][2][4][2];
#pragma unroll
    for (int a = 0; a < 2; ++a)
#pragma unroll
        for (int b = 0; b < 2; ++b)
#pragma unroll
            for (int m = 0; m < 4; ++m)
#pragma unroll
                for (int n = 0; n < 2; ++n) acc[a][b][m][n] = (f32x4){0.f, 0.f, 0.f, 0.f};
    bf16x8 At[4][2], B0[2][2], B1[2][2];
    const char* cA = (const char*)g.A + (size_t)cur.pm * tstep + (size_t)cur.kh * kpart; const char* cB = (const char*)g.Bt + (size_t)cur.pn * tstep + (size_t)cur.kh * kpart;
    S.a_ready(cur);
    if constexpr (SP2) {
        PG8_STAGE(PG8_SB(0, 0), cB, voffB); PG8_STAGE(PG8_SB(0, 1), cB + hstep, voffB); PG8_STAGE(PG8_SA(0, 0), cA, voffA); PG8_STAGE(PG8_SA(0, 1), cA + hstep, voffA);
        if (wr == 1) PG8_BAR;
        PG8_WAIT_V(2); PG8_BAR;
        PG8_STAGE(PG8_SB(1, 0), cB + kstep, voffB); PG8_STAGE(PG8_SA(1, 0), cA + kstep, voffA); PG8_STAGE(PG8_SB(1, 1), cB + hstep + kstep, voffB);
        PG8_WAIT_V(6); PG8_BAR;
    } else {
        PG8_STAGE(PG8_SB(0, 0), cB, voffB); PG8_STAGE(PG8_SA(0, 0), cA, voffA); PG8_STAGE(PG8_SB(0, 1), cB + hstep, voffB); PG8_STAGE(PG8_SA(0, 1), cA + hstep, voffA);
        if (wr == 1) PG8_BAR;
        PG8_WAIT_V(4); PG8_BAR;
        PG8_STAGE(PG8_SB(1, 0), cB + kstep, voffB); PG8_STAGE(PG8_SA(1, 0), cA + kstep, voffA); PG8_STAGE(PG8_SB(1, 1), cB + hstep + kstep, voffB);
        PG8_WAIT_V(6); PG8_BAR;
    }
    for (;;) {
        const bool has_next = S.next(ui + 1, nxt);
        const char* nA = has_next ? (const char*)g.A + (size_t)nxt.pm * tstep + (size_t)nxt.kh * kpart : cA; const char* nB = has_next ? (const char*)g.Bt + (size_t)nxt.pn * tstep + (size_t)nxt.kh * kpart : cB;
        for (int t = 0; t < nt; t += 2) {
            const bool last = (t == nt - 2);
            const char* a1 = cA + (size_t)(t + 1) * kstep;
            const char* a2 = last ? nA : cA + (size_t)(t + 2) * kstep; const char* b2 = last ? nB : cB + (size_t)(t + 2) * kstep;
            const char* a3 = a2 + kstep; const char* b3 = b2 + kstep;
            if (last && has_next) S.a_ready(nxt);
            if constexpr (SP2) {
            PG8_LDB(B0, 0, 0); PG8_LDB(B1, 0, 1); PG8_SCHED; PG8_LDA(At, 0, 0); PG8_STAGE(PG8_SA(1, 1), a1 + hstep, voffA);
            PG8_WAIT_V(8); PG8_WAIT_L(0); PG8_BAR; PG8_MMA(0, 0, At, B0); PG8_MMA(0, 1, At, B1); PG8_BAR; PG8_SCHED;
            PG8_LDA(At, 0, 1); PG8_STAGE(PG8_SB(0, 0), b2, voffB); PG8_STAGE(PG8_SB(0, 1), b2 + hstep, voffB); PG8_STAGE(PG8_SA(0, 0), a2, voffA);
            PG8_WAIT_V(8); PG8_WAIT_L(0); PG8_BAR; PG8_MMA(1, 0, At, B0); PG8_MMA(1, 1, At, B1); PG8_BAR; PG8_SCHED;
            PG8_LDB(B0, 1, 0); PG8_LDB(B1, 1, 1); PG8_SCHED; PG8_LDA(At, 1, 0); PG8_STAGE(PG8_SA(0, 1), a2 + hstep, voffA);
            PG8_WAIT_V(8); PG8_WAIT_L(0); PG8_BAR; PG8_MMA(0, 0, At, B0); PG8_MMA(0, 1, At, B1); PG8_BAR; PG8_SCHED;
            PG8_LDA(At, 1, 1); PG8_STAGE(PG8_SB(1, 0), b3, voffB); PG8_STAGE(PG8_SB(1, 1), b3 + hstep, voffB); PG8_STAGE(PG8_SA(1, 0), a3, voffA);
            PG8_WAIT_V(8); PG8_WAIT_L(0); PG8_BAR; PG8_MMA(1, 0, At, B0); PG8_MMA(1, 1, At, B1); PG8_BAR; PG8_SCHED;
            } else {
            PG8_LDB(B0, 0, 0); PG8_SCHED; PG8_LDA(At, 0, 0); PG8_STAGE(PG8_SA(1, 1), a1 + hstep, voffA);
            PG8_WAIT_L(8); PG8_BAR; PG8_WAIT_L(0); PG8_MMA(0, 0, At, B0); PG8_BAR; PG8_SCHED;
            PG8_LDB(B1, 0, 1); PG8_STAGE(PG8_SB(0, 0), b2, voffB);
            PG8_BAR; PG8_WAIT_L(0); PG8_MMA(0, 1, At, B1); PG8_BAR;
            PG8_LDA(At, 0, 1); PG8_STAGE(PG8_SA(0, 0), a2, voffA);
            PG8_BAR; PG8_WAIT_L(0); PG8_MMA(1, 0, At, B0); PG8_BAR; PG8_SCHED;
            PG8_STAGE(PG8_SB(0, 1), b2 + hstep, voffB);
            PG8_WAIT_V(6); PG8_BAR; PG8_MMA(1, 1, At, B1); PG8_BAR;
            PG8_LDB(B0, 1, 0); PG8_SCHED; PG8_LDA(At, 1, 0); PG8_STAGE(PG8_SA(0, 1), a2 + hstep, voffA);
            PG8_WAIT_L(8); PG8_BAR; PG8_WAIT_L(0); PG8_MMA(0, 0, At, B0); PG8_BAR; PG8_SCHED;
            PG8_LDB(B1, 1, 1); PG8_STAGE(PG8_SB(1, 0), b3, voffB);
            PG8_BAR; PG8_WAIT_L(0); PG8_MMA(0, 1, At, B1); PG8_BAR;
            PG8_LDA(At, 1, 1); PG8_STAGE(PG8_SA(1, 0), a3, voffA);
            PG8_BAR; PG8_WAIT_L(0); PG8_MMA(1, 0, At, B0); PG8_BAR; PG8_SCHED;
            PG8_STAGE(PG8_SB(1, 1), b3 + hstep, voffB);
            PG8_WAIT_V(6); PG8_BAR; PG8_MMA(1, 1, At, B1); PG8_BAR;
            }
        }
        if constexpr (ALIGN_EPI) { if (wr == 0) PG8_BAR; }
        if constexpr (!Epi::AFTER_DRAIN) { E(acc, cur, wr, wc, fr, fq); S.done(cur); }
        if (!has_next) break;
    #pragma unroll
        for (int a = 0; a < 2; ++a)
#pragma unroll
            for (int b = 0; b < 2; ++b)
#pragma unroll
                for (int m = 0; m < 4; ++m)
#pragma unroll
                    for (int n = 0; n < 2; ++n) acc[a][b][m][n] = (f32x4){0.f, 0.f, 0.f, 0.f};
        cur = nxt; cA = nA; cB = nB; ++ui;
        if constexpr (ALIGN_EPI) { if (wr == 1) PG8_BAR; }
    }
    PG8_WAIT_V(0);
    if constexpr (!ALIGN_EPI) { if (wr == 0) PG8_BAR; }
    PG8_BAR;
    if constexpr (Epi::AFTER_DRAIN) { E.fused(acc, cur, wr, wc, fr, fq, lds, wid, lane); S.done(cur); }
#undef PG8_SA
#undef PG8_SB
#undef PG8_STAGE
#undef PG8_LDA
#undef PG8_LDB
#undef PG8_MMA
#undef PG8_WAIT_V
#undef PG8_WAIT_L
#undef PG8_BAR
#undef PG8_SCHED
}
}

typedef unsigned short bf16;
typedef short bf16x8 __attribute__((ext_vector_type(8)));
typedef float f32x4 __attribute__((ext_vector_type(4)));
typedef float f32x16 __attribute__((ext_vector_type(16)));
typedef unsigned u32x4 __attribute__((ext_vector_type(4)));
typedef unsigned u32x2 __attribute__((ext_vector_type(2)));
typedef short s16x4 __attribute__((ext_vector_type(4)));
#define LAS __attribute__((address_space(3)))

constexpr int DM = 1024, T_CTX = 8192, T_LAT = 16384, TT = T_CTX + T_LAT, NL = 4;
constexpr int S_CTX = 256, S_LAT = 2048, B_CTX = 32, B_LAT = 8, PAST = 512;
constexpr int NZ = 2304, KVROWS = TT + B_LAT * PAST;
constexpr int HID = 4096;
constexpr float EPSN = 1e-6f;
constexpr float LOG2E = 1.4426950408889634f;
constexpr int ZC_AB = 0, ZC_AC = 256, ZC_AX = 512, ZC_U = 768, ZC_V = 1024, ZC_CQ = 1280, ZC_CKV = 1536, ZC_KPE = 1664, ZC_SQ = 1792, ZC_SK = 2048, ZC_SV = 2176;
enum { I_XP = 0, I_XS, I_CCKV, I_CKPE, I_CSK, I_CSV, I_C, I_CCTX, I_WADA, I_BADA, I_N1, I_N2, I_WIN, I_CONVW, I_SGUN, I_SGUW, I_SGUB, I_QN, I_WQUP, I_KVN, I_WKVUP, I_SINK, I_WOUT, I_W1, I_W2, I_FN };
constexpr size_t O_X = 0, O_CKV = (size_t)TT * DM, O_KPE = O_CKV + (size_t)B_CTX * NL * S_CTX * 128, O_SK = O_KPE + (size_t)B_CTX * NL * S_CTX * 32, O_SV = O_SK + (size_t)B_CTX * NL * S_CTX * 128;
constexpr size_t MiB = 1u << 20;
constexpr size_t WS_MOD = 0, WS_BAR = 896 * 1024;
constexpr size_t WSET = 23 * MiB;
constexpr size_t WS_WIN = 1 * MiB, WS_WOUT = WS_WIN + 4608 * 1024, WS_W1 = WS_WOUT + 2 * MiB, WS_W2 = WS_W1 + 8 * MiB, WS_WQ = WS_W2 + 8 * MiB, WS_WKV = WS_WQ + 256 * 1024, WS_WSGU = WS_WKV + 128 * 1024;
static_assert(WS_WSGU + 128 * 1024 <= 1 * MiB + WSET, "weight set size");
constexpr size_t WS_H = 47 * MiB, BIG0 = 95 * MiB;
constexpr size_t WS_Z = BIG0, WS_YCAT = BIG0 + 108 * MiB, WS_QMLA = BIG0 + 156 * MiB, WS_KVMLA = BIG0 + 180 * MiB, WS_CQN = BIG0 + 208 * MiB, WS_CKV = BIG0 + 220 * MiB, WS_KPE = BIG0 + 227 * MiB,
                 WS_QSWA = BIG0 + 229 * MiB, WS_KSWA = BIG0 + 241 * MiB, WS_VSWA = BIG0 + 248 * MiB, WS_HID = BIG0, WS_X16 = BIG0 + 255 * MiB, WS_PART = BIG0 + 192 * MiB, WS_END = BIG0 + 303 * MiB;
static_assert(WS_END <= 400 * MiB, "workspace budget");
constexpr int LDS_BYTES = 147456;
constexpr int NPHASE = 38;

struct Params { const float* in[26]; float* out; unsigned char* ws; int ph_lo, ph_hi; };
typedef const __attribute__((address_space(4))) Params CPAR;

__device__ __forceinline__ unsigned pk2(float lo, float hi) { return pg8::cvt_pk_bf16(lo, hi); }
__device__ __forceinline__ float bflo(unsigned w) { return __uint_as_float(w << 16); }
__device__ __forceinline__ float bfhi(unsigned w) { return __uint_as_float(w & 0xffff0000u); }
__device__ __forceinline__ float wave_sum(float v) {
#pragma unroll
    for (int o = 1; o < 64; o <<= 1) v += __shfl_xor(v, o);
    return v;
}
__device__ __forceinline__ int crow(int r, int hi) { return (r & 3) + 8 * (r >> 2) + 4 * hi; }
__device__ __forceinline__ int mod_idx(int t) { return t < T_CTX ? 0 : 1 + ((t - T_CTX) >> 11); }
__device__ __forceinline__ float gelu_tanh(float x) {
    const float y = 0.7978845608028654f * (x + 0.044715f * x * x * x);
    const float e = __expf(2.f * y);
    const float th = 1.f - 2.f / (e + 1.f);
    return 0.5f * x * (1.f + th);
}
__device__ __forceinline__ void sincos_red(float a, float& s, float& c) {
    const float k = rintf(a * 0.15915494309189535f);
    float r = fmaf(-k, 6.28318548202514648f, a);
    r = fmaf(-k, -1.7484555e-7f, r);
    s = __sinf(r); c = __cosf(r);
}

template <int ACT> struct EpiStore {
    static constexpr bool PERM = true, AFTER_DRAIN = false;
    bf16* O; int ldc;
    __device__ __forceinline__ void operator()(const f32x4 (&acc)[2][2][4][2], const pg8::Unit& u, int wr, int wc, int fr, int fq) const {
        const int row0 = u.pm * 256 + wr * 64 + fr, col0 = u.pn * 256 + wc * 32 + 8 * fq;
#pragma unroll
        for (int ai = 0; ai < 2; ++ai)
#pragma unroll
            for (int m = 0; m < 4; ++m) {
                bf16* rowp = O + (size_t)(row0 + ai * 128 + m * 16) * ldc + col0;
#pragma unroll
                for (int bj = 0; bj < 2; ++bj) {
                    f32x4 v0 = acc[ai][bj][m][0], v1 = acc[ai][bj][m][1];
                    if (ACT == 1) {
#pragma unroll
                        for (int j = 0; j < 4; ++j) { const float a = fmaxf(v0[j], 0.f), b = fmaxf(v1[j], 0.f); v0[j] = a * a; v1[j] = b * b; }
                    }
                    u32x4 w; w.x = pk2(v0[0], v0[1]); w.y = pk2(v0[2], v0[3]); w.z = pk2(v1[0], v1[1]); w.w = pk2(v1[2], v1[3]);
                    *(u32x4*)(rowp + bj * 128) = w;
                }
            }
    }
};
constexpr int SPLIT_ROW0 = 16384;
struct EpiRes {
    static constexpr bool PERM = true, AFTER_DRAIN = false;
    bf16* X; const float* gate_base; bf16* PART;
    __device__ __forceinline__ void operator()(const f32x4 (&acc)[2][2][4][2], const pg8::Unit& u, int wr, int wc, int fr, int fq) const {
        const int row0 = u.pm * 256 + wr * 64 + fr, col0 = u.pn * 256 + wc * 32 + 8 * fq;
        const float* gate = gate_base + (size_t)mod_idx(u.pm * 256) * 6144 + col0;
        f32x4 gv[2][2];
#pragma unroll
        for (int bj = 0; bj < 2; ++bj)
#pragma unroll
            for (int n = 0; n < 2; ++n) gv[bj][n] = *(const f32x4*)(gate + bj * 128 + 4 * n);
        if (u.kh != 0) {
            bf16* Pr = PART + (size_t)(row0 - SPLIT_ROW0) * DM + col0;
#pragma unroll
            for (int ai = 0; ai < 2; ++ai)
#pragma unroll
                for (int m = 0; m < 4; ++m)
#pragma unroll
                    for (int bj = 0; bj < 2; ++bj) {
                        const f32x4 a0 = acc[ai][bj][m][0] * gv[bj][0], a1 = acc[ai][bj][m][1] * gv[bj][1];
                        u32x4 w; w.x = pk2(a0[0], a0[1]); w.y = pk2(a0[2], a0[3]); w.z = pk2(a1[0], a1[1]); w.w = pk2(a1[2], a1[3]);
                        *(u32x4*)(Pr + (size_t)(ai * 128 + m * 16) * DM + bj * 128) = w;
                    }
            return;
        }
        bf16* Xr = X + (size_t)row0 * DM + col0;
        u32x4 xin[2][4][2];
#pragma unroll
        for (int ai = 0; ai < 2; ++ai)
#pragma unroll
            for (int m = 0; m < 4; ++m)
#pragma unroll
                for (int bj = 0; bj < 2; ++bj) xin[ai][m][bj] = *(const u32x4*)(Xr + (size_t)(ai * 128 + m * 16) * DM + bj * 128);
#pragma unroll
        for (int ai = 0; ai < 2; ++ai)
#pragma unroll
            for (int m = 0; m < 4; ++m)
#pragma unroll
                for (int bj = 0; bj < 2; ++bj) {
                    const u32x4 xi = xin[ai][m][bj];
                    const f32x4 a0 = acc[ai][bj][m][0] * gv[bj][0], a1 = acc[ai][bj][m][1] * gv[bj][1];
                    u32x4 w;
                    w.x = pk2(bflo(xi.x) + a0[0], bfhi(xi.x) + a0[1]); w.y = pk2(bflo(xi.y) + a0[2], bfhi(xi.y) + a0[3]);
                    w.z = pk2(bflo(xi.z) + a1[0], bfhi(xi.z) + a1[1]); w.w = pk2(bflo(xi.w) + a1[2], bfhi(xi.w) + a1[3]);
                    *(u32x4*)(Xr + (size_t)(ai * 128 + m * 16) * DM + bj * 128) = w;
                }
    }
};

__device__ __forceinline__ void phase_mod(CPAR& P, unsigned char* lds) {
    float* S = (float*)lds;
    float* Pp = (float*)(lds + 9 * 1024 * 4);
    const int tid = otid(), lane = tid & 63, wave = tid >> 6;
    const float* c = P.in[I_C]; const float* cctx = P.in[I_CCTX];
    for (int i = tid; i < 9 * 1024; i += 512) { const int r = i >> 10, k = i & 1023; const float v = (r == 0) ? cctx[k] : c[(r - 1) * 1024 + k]; S[i] = v / (1.f + __expf(-v)); }
    __syncthreads();
    float* mod = (float*)(P.ws + WS_MOD);
    for (int item = obx(); item < NL * 96; item += ogx()) {
        const int l = item / 96, j0 = (item % 96) * 64;
        const float* w = P.in[I_WADA] + (size_t)l * 1024 * 6144 + j0 + lane;
        float acc[9];
#pragma unroll
        for (int r = 0; r < 9; ++r) acc[r] = 0.f;
        const int k0 = wave * 128;
#pragma unroll 32
        for (int k = k0; k < k0 + 128; ++k) {
            const float wv = w[(size_t)k * 6144];
#pragma unroll
            for (int r = 0; r < 9; ++r) acc[r] = fmaf(S[r * 1024 + k], wv, acc[r]);
        }
#pragma unroll
        for (int r = 0; r < 9; ++r) Pp[(wave * 9 + r) * 64 + lane] = acc[r];
        __syncthreads();
        for (int i = tid; i < 9 * 64; i += 512) {
            const int r = i >> 6, ln = i & 63; float s = 0.f;
#pragma unroll
            for (int w8 = 0; w8 < 8; ++w8) s += Pp[(w8 * 9 + r) * 64 + ln];
            mod[((size_t)l * 9 + r) * 6144 + j0 + ln] = s + P.in[I_BADA][l * 6144 + j0 + ln];
        }
        __syncthreads();
    }
}

__device__ __forceinline__ void transpose_item(const float* W, int K, int N, bf16* WT, int thr, int shift, float* scr, int item, int lane) {
    const int nblk = N / 32, kb = item / nblk, nb = item % nblk, k0 = 64 * kb, n0 = 32 * nb;
    float tv[32];
#pragma unroll
    for (int i = 0; i < 32; ++i) tv[i] = W[(size_t)(k0 + 2 * i + (lane >> 5)) * N + n0 + (lane & 31)];
#pragma unroll
    for (int i = 0; i < 32; ++i) scr[(2 * i + (lane >> 5)) * 33 + (lane & 31)] = tv[i];
    asm volatile("s_waitcnt lgkmcnt(0)" ::: "memory");
    const int c = lane & 7;
    const int r0 = n0 + (n0 >= thr ? shift : 0);
#pragma unroll
    for (int j = 0; j < 4; ++j) { const int n = (lane >> 3) + 8 * j; const float* s = scr + (8 * c) * 33 + n;
        u32x4 o; o.x = pk2(s[0 * 33], s[1 * 33]); o.y = pk2(s[2 * 33], s[3 * 33]); o.z = pk2(s[4 * 33], s[5 * 33]); o.w = pk2(s[6 * 33], s[7 * 33]);
        *(u32x4*)(WT + (size_t)(r0 + n) * K + k0 + 8 * c) = o; }
    asm volatile("s_waitcnt lgkmcnt(0)" ::: "memory");
}
__device__ __forceinline__ void cvt_copy(const float* src, bf16* dst, size_t n4, size_t gt, size_t ngt) {
    for (size_t i = gt; i < n4; i += ngt) { const f32x4 v = *(const f32x4*)(src + 4 * i); u32x2 o; o.x = pk2(v[0], v[1]); o.y = pk2(v[2], v[3]); *(u32x2*)(dst + 4 * i) = o; }
}
__device__ __forceinline__ void phase_conv(CPAR& P, int l, unsigned char* lds, int b0, int nb) {
    const int tid = otid(), lane = tid & 63, wave = tid >> 6;
    float* scr = (float*)(lds + wave * 16384);
    const int gw = (obx() - b0) * 8 + wave, NGW = nb * 8;
    unsigned char* ws = P.ws + (size_t)(l & 1) * WSET;
    constexpr int I0 = 16 * 69, I1 = 16 * 32, I2 = 16 * 128, I3 = 64 * 32, I4 = 4 * 12, I5 = 2 * 16, NIT = I0 + I1 + I2 + I3 + I4 + I5;
    for (int it = gw; it < NIT; it += NGW) {
        int r = it;
        if (r < I0) { transpose_item(P.in[I_WIN] + (size_t)l * 1024 * 2208, 1024, 2208, (bf16*)(ws + WS_WIN), 1696, 96, scr, r, lane); continue; } r -= I0;
        if (r < I1) { transpose_item(P.in[I_WOUT] + (size_t)l * 1024 * 1024, 1024, 1024, (bf16*)(ws + WS_WOUT), 1 << 30, 0, scr, r, lane); continue; } r -= I1;
        if (r < I2) { transpose_item(P.in[I_W1] + (size_t)l * 1024 * 4096, 1024, 4096, (bf16*)(ws + WS_W1), 1 << 30, 0, scr, r, lane); continue; } r -= I2;
        if (r < I3) { transpose_item(P.in[I_W2] + (size_t)l * 4096 * 1024, 4096, 1024, (bf16*)(ws + WS_W2), 1 << 30, 0, scr, r, lane); continue; } r -= I3;
        if (r < I4) { transpose_item(P.in[I_WQUP] + (size_t)l * 256 * 384, 256, 384, (bf16*)(ws + WS_WQ), 1 << 30, 0, scr, r, lane); continue; } r -= I4;
        transpose_item(P.in[I_WKVUP] + (size_t)l * 128 * 512, 128, 512, (bf16*)(ws + WS_WKV), 1 << 30, 0, scr, r, lane);
    }
    const size_t gt = (size_t)(obx() - b0) * 512 + tid, ngt = (size_t)nb * 512;
    { unsigned zz_ = 0u; asm volatile("" : "+v"(zz_)); u32x4 z = {zz_, zz_, zz_, zz_};
      u32x4* p0 = (u32x4*)((bf16*)(ws + WS_WIN) + (size_t)1696 * 1024); for (size_t i = gt; i < 96 * 1024 / 8; i += ngt) p0[i] = z;
      u32x4* p1 = (u32x4*)((bf16*)(ws + WS_WQ) + (size_t)384 * 256); for (size_t i = gt; i < 128 * 256 / 8; i += ngt) p1[i] = z; }
    cvt_copy(P.in[I_SGUW] + (size_t)l * 4 * 128 * 128, (bf16*)(ws + WS_WSGU), 4 * 128 * 128 / 4, gt, ngt);
    for (int b = 0; b < B_LAT; ++b) {
        cvt_copy(P.in[I_CCKV] + ((size_t)(b * NL + l) * PAST) * 128, (bf16*)(P.ws + WS_CKV) + (size_t)(TT + b * PAST) * 128, PAST * 128 / 4, gt, ngt);
        cvt_copy(P.in[I_CKPE] + ((size_t)(b * NL + l) * PAST) * 32, (bf16*)(P.ws + WS_KPE) + (size_t)(TT + b * PAST) * 32, PAST * 32 / 4, gt, ngt);
        cvt_copy(P.in[I_CSK] + ((size_t)(b * NL + l) * PAST) * 128, (bf16*)(P.ws + WS_KSWA) + (size_t)(TT + b * PAST) * 128, PAST * 128 / 4, gt, ngt);
        cvt_copy(P.in[I_CSV] + ((size_t)(b * NL + l) * PAST) * 128, (bf16*)(P.ws + WS_VSWA) + (size_t)(TT + b * PAST) * 128, PAST * 128 / 4, gt, ngt);
    }
}

__device__ __forceinline__ void phase_norm(CPAR& P, int l, int which, bool first, bool addpart) {
    const int tid = otid(), lane = tid & 63, wave = tid >> 6;
    const int gw = obx() * 8 + wave, NGW = ogx() * 8;
    const float* mod = (const float*)(P.ws + WS_MOD) + (size_t)l * 9 * 6144;
    const float* g = P.in[which == 0 ? I_N1 : I_N2] + l * 1024;
    bf16* X = (bf16*)(P.ws + WS_X16); bf16* H = (bf16*)(P.ws + WS_H);
    const int shoff = which == 0 ? 0 : 3 * 1024, scoff = shoff + 1024;
    int cur = -1; f32x4 cg4[4], sh4[4];
    for (int t0 = 4 * gw; t0 < TT; t0 += 4 * NGW) {
        const int idx = mod_idx(t0);
        if (idx != cur) { cur = idx;
#pragma unroll
            for (int j = 0; j < 4; ++j) { const int c0 = 4 * lane + 256 * j; const f32x4 gg = *(const f32x4*)(g + c0), sc = *(const f32x4*)(mod + idx * 6144 + scoff + c0); sh4[j] = *(const f32x4*)(mod + idx * 6144 + shoff + c0); cg4[j] = gg * (sc + 1.f); } }
        f32x4 v[4][4]; float ss[4];
        if (first) {
#pragma unroll
            for (int r = 0; r < 4; ++r) { const int t = t0 + r; const float* xr = t < T_CTX ? P.in[I_XP] + (size_t)t * DM : P.in[I_XS] + (size_t)(t - T_CTX) * DM;
#pragma unroll
                for (int j = 0; j < 4; ++j) v[r][j] = *(const f32x4*)(xr + 4 * lane + 256 * j); }
#pragma unroll
            for (int r = 0; r < 4; ++r)
#pragma unroll
                for (int j = 0; j < 4; ++j) { u32x2 w; w.x = pk2(v[r][j][0], v[r][j][1]); w.y = pk2(v[r][j][2], v[r][j][3]); *(u32x2*)(X + (size_t)(t0 + r) * DM + 4 * lane + 256 * j) = w; }
        } else {
            u32x2 w[4][4];
#pragma unroll
            for (int r = 0; r < 4; ++r)
#pragma unroll
                for (int j = 0; j < 4; ++j) w[r][j] = *(const u32x2*)(X + (size_t)(t0 + r) * DM + 4 * lane + 256 * j);
#pragma unroll
            for (int r = 0; r < 4; ++r)
#pragma unroll
                for (int j = 0; j < 4; ++j) v[r][j] = (f32x4){bflo(w[r][j].x), bfhi(w[r][j].x), bflo(w[r][j].y), bfhi(w[r][j].y)};
            if (addpart && t0 >= SPLIT_ROW0) {
                const bf16* PT = (const bf16*)(P.ws + WS_PART);
#pragma unroll
                for (int r = 0; r < 4; ++r)
#pragma unroll
                    for (int j = 0; j < 4; ++j) w[r][j] = *(const u32x2*)(PT + (size_t)(t0 + r - SPLIT_ROW0) * DM + 4 * lane + 256 * j);
#pragma unroll
                for (int r = 0; r < 4; ++r)
#pragma unroll
                    for (int j = 0; j < 4; ++j) { v[r][j] += (f32x4){bflo(w[r][j].x), bfhi(w[r][j].x), bflo(w[r][j].y), bfhi(w[r][j].y)};
                        u32x2 o; o.x = pk2(v[r][j][0], v[r][j][1]); o.y = pk2(v[r][j][2], v[r][j][3]); *(u32x2*)(X + (size_t)(t0 + r) * DM + 4 * lane + 256 * j) = o;
                        v[r][j] = (f32x4){bflo(o.x), bfhi(o.x), bflo(o.y), bfhi(o.y)}; }
            }
        }
#pragma unroll
        for (int r = 0; r < 4; ++r) { float s = 0.f;
#pragma unroll
            for (int j = 0; j < 4; ++j) s += (v[r][j][0] * v[r][j][0] + v[r][j][1] * v[r][j][1]) + (v[r][j][2] * v[r][j][2] + v[r][j][3] * v[r][j][3]);
            ss[r] = s; }
#pragma unroll
        for (int o = 1; o < 64; o <<= 1) {
#pragma unroll
            for (int r = 0; r < 4; ++r) ss[r] += __shfl_xor(ss[r], o); }
#pragma unroll
        for (int r = 0; r < 4; ++r) { const float rs = rsqrtf(ss[r] * (1.f / DM) + EPSN);
#pragma unroll
            for (int j = 0; j < 4; ++j) {
                const f32x4 o = v[r][j] * rs * cg4[j] + sh4[j];
                u32x2 w; w.x = pk2(o[0], o[1]); w.y = pk2(o[2], o[3]);
                *(u32x2*)(H + (size_t)(t0 + r) * DM + 4 * lane + 256 * j) = w;
            } }
    }
}
__device__ __forceinline__ void phase_final(CPAR& P, bool addpart) {
    const int tid = otid(), lane = tid & 63, wave = tid >> 6;
    const int gw = obx() * 8 + wave, NGW = ogx() * 8;
    const bf16* X = (const bf16*)(P.ws + WS_X16); float* Y = P.out + O_X; const float* g = P.in[I_FN];
    f32x4 g4[4];
#pragma unroll
    for (int j = 0; j < 4; ++j) g4[j] = *(const f32x4*)(g + 4 * lane + 256 * j);
    for (int t = gw; t < TT; t += NGW) {
        f32x4 v[4]; float ss = 0.f;
#pragma unroll
        for (int j = 0; j < 4; ++j) { const u32x2 w = *(const u32x2*)(X + (size_t)t * DM + 4 * lane + 256 * j); v[j] = (f32x4){bflo(w.x), bfhi(w.x), bflo(w.y), bfhi(w.y)};
            if (addpart && t >= SPLIT_ROW0) { const u32x2 q = *(const u32x2*)((const bf16*)(P.ws + WS_PART) + (size_t)(t - SPLIT_ROW0) * DM + 4 * lane + 256 * j); v[j] += (f32x4){bflo(q.x), bfhi(q.x), bflo(q.y), bfhi(q.y)};
                const u32x2 o = {pk2(v[j][0], v[j][1]), pk2(v[j][2], v[j][3])}; v[j] = (f32x4){bflo(o.x), bfhi(o.x), bflo(o.y), bfhi(o.y)}; }
            ss += (v[j][0] * v[j][0] + v[j][1] * v[j][1]) + (v[j][2] * v[j][2] + v[j][3] * v[j][3]); }
        const float rs = rsqrtf(wave_sum(ss) * (1.f / DM) + EPSN);
#pragma unroll
        for (int j = 0; j < 4; ++j) *(f32x4*)(Y + (size_t)t * DM + 4 * lane + 256 * j) = v[j] * rs * g4[j];
    }
}

__device__ __forceinline__ void ld4bf(const bf16* p, float (&v)[4]) { const u32x2 w = *(const u32x2*)p; v[0] = bflo(w.x); v[1] = bfhi(w.x); v[2] = bflo(w.y); v[3] = bfhi(w.y); }
__device__ __forceinline__ void st4bf(bf16* p, const float (&v)[4]) { u32x2 w; w.x = pk2(v[0], v[1]); w.y = pk2(v[2], v[3]); *(u32x2*)p = w; }
__device__ __forceinline__ void cv8(const u32x4 w, float (&v)[8]) { v[0] = bflo(w.x); v[1] = bfhi(w.x); v[2] = bflo(w.y); v[3] = bfhi(w.y); v[4] = bflo(w.z); v[5] = bfhi(w.z); v[6] = bflo(w.w); v[7] = bfhi(w.w); }
__device__ __forceinline__ void st8bf(bf16* p, const float (&v)[8]) { u32x4 w; w.x = pk2(v[0], v[1]); w.y = pk2(v[2], v[3]); w.z = pk2(v[4], v[5]); w.w = pk2(v[6], v[7]); *(u32x4*)p = w; }
__device__ __forceinline__ void phase_mid_rows(CPAR& P, int l) {
    const int tid = otid(), lane = tid & 63, wave = tid >> 6, l32 = lane & 31, half = lane >> 5;
    const int gw = obx() * 8 + wave, NGW = ogx() * 8;
    unsigned char* ws = P.ws;
    const bf16* Z = (const bf16*)(ws + WS_Z);
    bf16* YC = (bf16*)(ws + WS_YCAT); bf16* CQN = (bf16*)(ws + WS_CQN); bf16* CKV = (bf16*)(ws + WS_CKV); bf16* KPE = (bf16*)(ws + WS_KPE);
    bf16* QS = (bf16*)(ws + WS_QSWA); bf16* KS = (bf16*)(ws + WS_KSWA); bf16* VS = (bf16*)(ws + WS_VSWA);
    const int c8 = 8 * l32;
    float cw0[8], cw1[8], cw2[8], qn[8], kvn[8], f64[8], f32r[8];
#pragma unroll
    for (int j = 0; j < 8; ++j) {
        cw0[j] = P.in[I_CONVW][l * 768 + c8 + j]; cw1[j] = P.in[I_CONVW][l * 768 + 256 + c8 + j]; cw2[j] = P.in[I_CONVW][l * 768 + 512 + c8 + j];
        qn[j] = P.in[I_QN][l * 256 + c8 + j]; kvn[j] = P.in[I_KVN][l * 128 + ((c8 + j) & 127)];
        f64[j] = exp2f(-(float)(((c8 & 63) + j) & 15) * (13.287712379549449f / 16.f));
        f32r[j] = exp2f(-(float)j * (13.287712379549449f / 8.f));
    }
    const bool usecol64 = ((c8 & 63) >= 32); const float sgn64 = ((c8 & 63) & 16) ? 1.f : -1.f;
    const bool usecol32 = (l32 & 2) != 0; const float sgn32 = (l32 & 1) ? 1.f : -1.f;
    const u32x4 z4 = {0u, 0u, 0u, 0u};
    for (int t0 = 2 * gw; t0 < TT; t0 += 2 * NGW) {
        const int t = t0 + half;
        const bool lat = t >= T_CTX;
        const int S = lat ? S_LAT : S_CTX, tl = lat ? t - T_CTX : t, b = lat ? tl >> 11 : tl >> 8, s = tl & (S - 1);
        const bf16* zr = Z + (size_t)t * NZ;
        const u32x4 w_ab = __builtin_nontemporal_load((const u32x4*)(zr + ZC_AB + c8)), w_ac = *(const u32x4*)(zr + ZC_AC + c8), w_ax = *(const u32x4*)(zr + ZC_AX + c8);
        u32x4 w_acp = z4, w_axp = z4, w_acn = z4, w_axn = z4, w_ckv = z4, w_sk = z4, w_sv = z4, w_kpe = z4;
        if (s > 0) { w_acp = *(const u32x4*)(zr - NZ + ZC_AC + c8); w_axp = *(const u32x4*)(zr - NZ + ZC_AX + c8); }
        if (s < S - 1) { w_acn = *(const u32x4*)(zr + NZ + ZC_AC + c8); w_axn = *(const u32x4*)(zr + NZ + ZC_AX + c8); }
        const u32x4 w_cq = __builtin_nontemporal_load((const u32x4*)(zr + ZC_CQ + c8)), w_sq = __builtin_nontemporal_load((const u32x4*)(zr + ZC_SQ + c8));
        if (l32 < 16) { w_ckv = __builtin_nontemporal_load((const u32x4*)(zr + ZC_CKV + c8)); w_sk = __builtin_nontemporal_load((const u32x4*)(zr + ZC_SK + c8)); w_sv = __builtin_nontemporal_load((const u32x4*)(zr + ZC_SV + c8)); }
        if (l32 < 4) w_kpe = __builtin_nontemporal_load((const u32x4*)(zr + ZC_KPE + c8));
        { float ab[8], ac[8], ax[8], acp[8], axp[8], acn[8], axn[8], y[8];
          cv8(w_ab, ab); cv8(w_ac, ac); cv8(w_ax, ax); cv8(w_acp, acp); cv8(w_axp, axp); cv8(w_acn, acn); cv8(w_axn, axn);
#pragma unroll
          for (int j = 0; j < 8; ++j) y[j] = ab[j] * (cw0[j] * (acp[j] * axp[j]) + cw1[j] * (ac[j] * ax[j]) + cw2[j] * (acn[j] * axn[j]));
          st8bf(YC + (size_t)t * DM + c8, y); }
        { float v[8]; cv8(w_cq, v); float ss = 0.f;
#pragma unroll
          for (int j = 0; j < 8; ++j) ss += v[j] * v[j];
#pragma unroll
          for (int o = 1; o < 32; o <<= 1) ss += __shfl_xor(ss, o);
          const float rs = rsqrtf(ss * (1.f / 256.f) + EPSN);
#pragma unroll
          for (int j = 0; j < 8; ++j) v[j] = v[j] * rs * qn[j];
          st8bf(CQN + (size_t)t * 256 + c8, v); }
        { float v[8]; cv8(w_ckv, v); float ss = 0.f;
#pragma unroll
          for (int j = 0; j < 8; ++j) ss += v[j] * v[j];
#pragma unroll
          for (int o = 1; o < 32; o <<= 1) ss += __shfl_xor(ss, o);
          const float rs = rsqrtf(ss * (1.f / 128.f) + EPSN);
          if (l32 < 16) {
#pragma unroll
              for (int j = 0; j < 8; ++j) v[j] = v[j] * rs * kvn[j];
              st8bf(CKV + (size_t)t * 128 + c8, v);
              if (!lat) { float* oc = P.out + O_CKV + ((size_t)(b * NL + l) * S_CTX + s) * 128 + c8; *(f32x4*)oc = (f32x4){v[0], v[1], v[2], v[3]}; *(f32x4*)(oc + 4) = (f32x4){v[4], v[5], v[6], v[7]}; }
          } }
        const float prow = (float)(s >> 6), pcol = (float)(s & 63);
        { float v[8], o[8]; cv8(w_kpe, v);
#pragma unroll
          for (int j = 0; j < 8; ++j) { const float pv = __shfl_xor(v[j], 1); o[j] = v[j];
              if (lat && l32 < 4) { float sn, cs; sincos_red((usecol32 ? pcol : prow) * f32r[j], sn, cs); o[j] = v[j] * cs + sgn32 * pv * sn; } }
          if (l32 < 4) {
              if (!lat) { float* ok = P.out + O_KPE + ((size_t)(b * NL + l) * S_CTX + s) * 32 + c8; *(f32x4*)ok = (f32x4){v[0], v[1], v[2], v[3]}; *(f32x4*)(ok + 4) = (f32x4){v[4], v[5], v[6], v[7]}; }
              st8bf(KPE + (size_t)t * 32 + c8, o); } }
        { float cs[8], sn[8];
          if (lat) {
#pragma unroll
              for (int j = 0; j < 8; ++j) sincos_red((usecol64 ? pcol : prow) * f64[j], sn[j], cs[j]); }
          float q[8], k[8], vv[8], qo[8], ko[8]; cv8(w_sq, q); cv8(w_sk, k); cv8(w_sv, vv);
#pragma unroll
          for (int j = 0; j < 8; ++j) { const float qp = __shfl_xor(q[j], 2), kp = __shfl_xor(k[j], 2);
              qo[j] = lat ? q[j] * cs[j] + sgn64 * qp * sn[j] : q[j]; ko[j] = lat ? k[j] * cs[j] + sgn64 * kp * sn[j] : k[j]; }
          st8bf(QS + (size_t)t * 256 + c8, qo);
          if (l32 < 16) { st8bf(KS + (size_t)t * 128 + c8, ko); st8bf(VS + (size_t)t * 128 + c8, vv);
              if (!lat) { const size_t oo = ((size_t)(b * NL + l) * S_CTX + s) * 128 + c8;
                  *(f32x4*)(P.out + O_SK + oo) = (f32x4){k[0], k[1], k[2], k[3]}; *(f32x4*)(P.out + O_SK + oo + 4) = (f32x4){k[4], k[5], k[6], k[7]};
                  *(f32x4*)(P.out + O_SV + oo) = (f32x4){vv[0], vv[1], vv[2], vv[3]}; *(f32x4*)(P.out + O_SV + oo + 4) = (f32x4){vv[4], vv[5], vv[6], vv[7]}; } } }
    }
}
__device__ __forceinline__ bf16x8 tr_pair(const LAS unsigned char* p0, const LAS unsigned char* p1) {
    const s16x4 a = __builtin_bit_cast(s16x4, __builtin_amdgcn_ds_read_tr16_b64_v4i16((LAS s16x4*)p0));
    const s16x4 b = __builtin_bit_cast(s16x4, __builtin_amdgcn_ds_read_tr16_b64_v4i16((LAS s16x4*)p1));
    return (bf16x8){a[0], a[1], a[2], a[3], b[0], b[1], b[2], b[3]};
}
constexpr int SG_LD = 272;
__device__ __forceinline__ void phase_mid_sgu(CPAR& P, int l, unsigned char* lds) {
    const int tid = otid(), lane = tid & 63, wave = tid >> 6, r32 = lane & 31, hi = lane >> 5;
    unsigned char* ws = P.ws;
    const bf16* Z = (const bf16*)(ws + WS_Z); bf16* YC = (bf16*)(ws + WS_YCAT); const bf16* WS_ = (const bf16*)(ws + (size_t)(l & 1) * WSET + WS_WSGU);
    bf16* U = (bf16*)lds; bf16* V = (bf16*)(lds + 128 * SG_LD * 2);
    const LAS unsigned char* Vl = (const LAS unsigned char*)(LAS unsigned char*)lds + 128 * SG_LD * 2;
    const int cgp = tid & 31, rr0 = tid >> 5;
    float gn[8];
#pragma unroll
    for (int j = 0; j < 8; ++j) gn[j] = P.in[I_SGUN][l * 256 + cgp * 8 + j];
    for (int chunk = obx(); chunk < TT / 128; chunk += ogx()) {
        const int t0 = chunk * 128;
        u32x4 ura[8], vra[8];
#pragma unroll
        for (int i = 0; i < 8; ++i) { const int row = rr0 + 16 * i; ura[i] = *(const u32x4*)(Z + (size_t)(t0 + row) * NZ + ZC_U + cgp * 8); vra[i] = *(const u32x4*)(Z + (size_t)(t0 + row) * NZ + ZC_V + cgp * 8); }
#pragma unroll
        for (int i = 0; i < 8; ++i) {
            const int row = rr0 + 16 * i;
            const u32x4 ur = ura[i], vr = vra[i];
            float u[8], v[8];
#pragma unroll
            for (int j = 0; j < 4; ++j) { u[2 * j] = gelu_tanh(bflo(ur[j])); u[2 * j + 1] = gelu_tanh(bfhi(ur[j])); v[2 * j] = gelu_tanh(bflo(vr[j])); v[2 * j + 1] = gelu_tanh(bfhi(vr[j])); }
            float ss = 0.f;
#pragma unroll
            for (int j = 0; j < 8; ++j) ss += v[j] * v[j];
#pragma unroll
            for (int o = 1; o < 32; o <<= 1) ss += __shfl_xor(ss, o);
            const float rs = rsqrtf(ss * (1.f / 256.f) + EPSN);
            u32x4 uo, vo;
#pragma unroll
            for (int j = 0; j < 4; ++j) { uo[j] = pk2(u[2 * j], u[2 * j + 1]); vo[j] = pk2(v[2 * j] * rs * gn[2 * j], v[2 * j + 1] * rs * gn[2 * j + 1]); }
            *(u32x4*)(U + row * SG_LD + cgp * 8) = uo; *(u32x4*)(V + row * SG_LD + cgp * 8) = vo;
        }
        __syncthreads();
        const int h = wave >> 1, ph = wave & 1;
        f32x16 acc[2][2];
#pragma unroll
        for (int a = 0; a < 2; ++a)
#pragma unroll
            for (int b2 = 0; b2 < 2; ++b2)
#pragma unroll
                for (int r = 0; r < 16; ++r) acc[a][b2][r] = 0.f;
#pragma unroll 2
        for (int ks = 0; ks < 8; ++ks) {
            const int k0 = 16 * ks;
            bf16x8 af[2], bfr[2];
#pragma unroll
            for (int mi = 0; mi < 2; ++mi) af[mi] = *(const bf16x8*)(WS_ + ((size_t)(h * 128 + ph * 64 + mi * 32 + r32)) * 128 + k0 + 8 * hi);
#pragma unroll
            for (int ni = 0; ni < 2; ++ni) {
                const int rowa = k0 + 8 * hi + ((lane & 15) >> 2), col = h * 64 + ni * 32 + 16 * ((lane >> 4) & 1) + 4 * (lane & 3);
                bfr[ni] = tr_pair(Vl + (rowa * SG_LD + col) * 2, Vl + ((rowa + 4) * SG_LD + col) * 2);
            }
#pragma unroll
            for (int mi = 0; mi < 2; ++mi)
#pragma unroll
                for (int ni = 0; ni < 2; ++ni) acc[mi][ni] = __builtin_amdgcn_mfma_f32_32x32x16_bf16(bfr[ni], af[mi], acc[mi][ni], 0, 0, 0);
        }
        const float* bs = P.in[I_SGUB] + (l * 4 + h) * 128;
#pragma unroll
        for (int mi = 0; mi < 2; ++mi) {
            const int p = ph * 64 + mi * 32 + r32; const float bb = bs[p];
#pragma unroll
            for (int ni = 0; ni < 2; ++ni)
#pragma unroll
                for (int i4 = 0; i4 < 4; ++i4) {
                    const int d = h * 64 + ni * 32 + 8 * i4 + 4 * hi;
                    const u32x2 uw = *(const u32x2*)(U + p * SG_LD + d);
                    u32x2 w; w.x = pk2((acc[mi][ni][4 * i4] + bb) * bflo(uw.x), (acc[mi][ni][4 * i4 + 1] + bb) * bfhi(uw.x));
                    w.y = pk2((acc[mi][ni][4 * i4 + 2] + bb) * bflo(uw.y), (acc[mi][ni][4 * i4 + 3] + bb) * bfhi(uw.y));
                    *(u32x2*)(YC + (size_t)(t0 + p) * DM + 256 + d) = w;
                }
        }
        __syncthreads();
    }
}

constexpr int VLD = 96;
template <bool MLA>
__device__ __forceinline__ void attn_unit(CPAR& P, int l, LAS unsigned char* lds, bool lat, int b, int hh, int qb) {
    constexpr int DK = MLA ? 96 : 64, NS = DK / 16, KLD = MLA ? 104 : 72;
    const int tid = otid(), lane = tid & 63, wave = __builtin_amdgcn_readfirstlane(tid >> 6), r32 = lane & 31, hi = lane >> 5;
    unsigned char* ws = P.ws;
    bf16* YC = (bf16*)(ws + WS_YCAT);
    const int S = lat ? S_LAT : S_CTX;
    const int tokbase = lat ? T_CTX + b * S_LAT : b * S_CTX;
    int qpos, qcol, qstride, g = 0; const bf16* Qp;
    if (MLA) { qpos = qb * 256 + wave * 32 + r32; qcol = hh * 96; Qp = (const bf16*)(ws + WS_QMLA); qstride = 512; }
    else { g = wave >> 2; qpos = qb * 128 + (wave & 3) * 32 + r32; qcol = (hh * 2 + g) * 64; Qp = (const bf16*)(ws + WS_QSWA); qstride = 256; }
    const int tq = tokbase + qpos;
    bf16x8 qf[NS];
#pragma unroll
    for (int s = 0; s < NS; ++s) qf[s] = *(const bf16x8*)(Qp + (size_t)tq * qstride + qcol + 16 * s + 8 * hi);
    if (MLA && lat) {
        const float prow = (float)(qpos >> 6), pcol = (float)(qpos & 63);
        const float sg = hi ? 1.f : -1.f;
#pragma unroll
        for (int s = 4; s < 6; ++s) {
            const float pos = (s == 4) ? prow : pcol;
            u32x4 w = __builtin_bit_cast(u32x4, qf[s]); u32x4 wo;
#pragma unroll
            for (int j = 0; j < 4; ++j) {
                const unsigned pw = (unsigned)__shfl_xor((int)w[j], 32);
                float s0, c0, s1, c1;
                sincos_red(pos * exp2f(-(float)(2 * j) * (13.287712379549449f / 8.f)), s0, c0);
                sincos_red(pos * exp2f(-(float)(2 * j + 1) * (13.287712379549449f / 8.f)), s1, c1);
                const float o0 = bflo(w[j]) * c0 + sg * bflo(pw) * s0, o1 = bfhi(w[j]) * c1 + sg * bfhi(pw) * s1;
                wo[j] = pk2(o0, o1);
            }
            qf[s] = __builtin_bit_cast(bf16x8, wo);
        }
    }
    {
        const float cq = (MLA ? 0.10206207261596577f : 0.125f) * LOG2E;
#pragma unroll
        for (int s = 0; s < NS; ++s) { u32x4 w = __builtin_bit_cast(u32x4, qf[s]);
#pragma unroll
            for (int j = 0; j < 4; ++j) w[j] = pk2(bflo(w[j]) * cq, bfhi(w[j]) * cq);
            qf[s] = __builtin_bit_cast(bf16x8, w); }
    }
    int lo0, n0, n1; bool masked;
    if (MLA) { lo0 = 0; n0 = S / 64; n1 = lat ? PAST / 64 : 0; masked = false; }
    else if (lat) { const int q0 = qb * 128; lo0 = q0 - 128 < 0 ? 0 : q0 - 128; const int hi0 = q0 + 256 > S_LAT ? S_LAT : q0 + 256; n0 = (hi0 - lo0) / 64; n1 = PAST / 64; masked = true; }
    else { lo0 = 0; n0 = S_CTX / 64; n1 = 0; masked = false; }
    const int ntile = n0 + n1, seg1row = TT + b * PAST;
    const bf16* Kmain; const bf16* Vsrc; int kstride;
    if (MLA) { Kmain = (const bf16*)(ws + WS_KVMLA) + hh * 128; Vsrc = Kmain + 64; kstride = 512; }
    else { Kmain = (const bf16*)(ws + WS_KSWA) + hh * 64; Vsrc = (const bf16*)(ws + WS_VSWA) + hh * 64; kstride = 128; }
    const bf16* KPEp = (const bf16*)(ws + WS_KPE);
    const int lrow = tid >> 3, lch = tid & 7, erow = (tid >> 2) & 63, ech = tid & 3;
    constexpr int BUFB = 64 * 104 * 2 + 64 * VLD * 2;
    u32x4 kreg, vreg, ereg = {0u, 0u, 0u, 0u};
#define ATT_LOAD(it_) do { const int it__ = (it_); const int row0 = it__ < n0 ? tokbase + lo0 + it__ * 64 : seg1row + (it__ - n0) * 64; \
        kreg = *(const u32x4*)(Kmain + (size_t)(row0 + lrow) * kstride + lch * 8); vreg = *(const u32x4*)(Vsrc + (size_t)(row0 + lrow) * kstride + lch * 8); \
        if (MLA && tid < 256) ereg = *(const u32x4*)(KPEp + (size_t)(row0 + erow) * 32 + ech * 8); } while (0)
#define ATT_STORE(buf_) do { LAS unsigned char* Kw = lds + (buf_) * BUFB; LAS unsigned char* Vw = Kw + 64 * 104 * 2; \
        *(LAS u32x4*)(Kw + (lrow * KLD + lch * 8) * 2) = kreg; *(LAS u32x4*)(Vw + (lrow * VLD + lch * 8) * 2) = vreg; \
        if (MLA && tid < 256) *(LAS u32x4*)(Kw + (erow * KLD + 64 + ech * 8) * 2) = ereg; } while (0)
    ATT_LOAD(0);
    float mref, lsum;
    if (MLA) { mref = 0.f; lsum = 0.f; } else { const float sk2 = P.in[I_SINK][l * 4 + hh * 2 + g] * LOG2E; mref = bflo(pk2(sk2, 0.f)); lsum = hi ? 0.f : __builtin_amdgcn_exp2f(sk2 - mref); }
    int zi_ = 0; asm volatile("" : "+v"(zi_)); const short z_ = (short)zi_;
    const bf16x8 kx = {hi ? z_ : (short)0x3F80, z_, z_, z_, z_, z_, z_, z_};
    bf16x8 qx = {z_, z_, z_, z_, z_, z_, z_, z_};
    if (!hi) qx[0] = (short)(pk2(-mref, 0.f) & 0xffffu);
    const f32x16 zero16 = {0.f, 0.f, 0.f, 0.f, 0.f, 0.f, 0.f, 0.f, 0.f, 0.f, 0.f, 0.f, 0.f, 0.f, 0.f, 0.f};
    constexpr float THR = 8.f;
    f32x16 o[2];
#pragma unroll
    for (int r = 0; r < 16; ++r) { o[0][r] = 0.f; o[1][r] = 0.f; }
    const int trr = (lane & 15) >> 2, trc = 16 * ((lane >> 4) & 1) + 4 * (lane & 3);
    __syncthreads();
    ATT_STORE(0);
    __syncthreads();
    for (int it = 0; it < ntile; ++it) {
        LAS unsigned char* Kl = lds + (it & 1) * BUFB; LAS unsigned char* Vl = Kl + 64 * 104 * 2;
        if (it + 1 < ntile) ATT_LOAD(it + 1);
        bf16x8 qx2 = qx; asm volatile("" : "+v"(qx2));
        f32x16 p0 = __builtin_amdgcn_mfma_f32_32x32x16_bf16(kx, qx, zero16, 0, 0, 0), p1 = __builtin_amdgcn_mfma_f32_32x32x16_bf16(kx, qx2, zero16, 0, 0, 0);
#pragma unroll
        for (int s = 0; s < NS; ++s) {
            const bf16x8 k0 = *(const LAS bf16x8*)(Kl + (r32 * KLD + 16 * s + 8 * hi) * 2), k1 = *(const LAS bf16x8*)(Kl + ((32 + r32) * KLD + 16 * s + 8 * hi) * 2);
            p0 = __builtin_amdgcn_mfma_f32_32x32x16_bf16(k0, qf[s], p0, 0, 0, 0); p1 = __builtin_amdgcn_mfma_f32_32x32x16_bf16(k1, qf[s], p1, 0, 0, 0);
        }
        if (masked && it < n0) {
            const int dq = qpos - (lo0 + it * 64) - 4 * hi;
#pragma unroll
            for (int r = 0; r < 16; ++r) { const int d0 = dq - ((r & 3) + 8 * (r >> 2)), d1 = d0 - 32;
                if (d0 > 128 || d0 < -128) p0[r] = -INFINITY; if (d1 > 128 || d1 < -128) p1[r] = -INFINITY; }
        }
        float mx;
        { float a = fmaxf(fmaxf(p0[0], p0[1]), p1[0]), b = fmaxf(fmaxf(p0[2], p0[3]), p1[1]); a = fmaxf(fmaxf(a, p1[2]), p1[3]);
#pragma unroll
          for (int r = 4; r < 16; r += 4) { a = fmaxf(fmaxf(a, p0[r]), p0[r + 1]); b = fmaxf(fmaxf(b, p0[r + 2]), p0[r + 3]); a = fmaxf(fmaxf(a, p1[r]), p1[r + 1]); b = fmaxf(fmaxf(b, p1[r + 2]), p1[r + 3]); }
          mx = fmaxf(a, b); }
        mx = fmaxf(mx, __shfl_xor(mx, 32));
        const bool first = MLA && it == 0;
        if (first || __any(mx > THR)) {
            const float mnew = bflo(pk2(mref + (first ? mx : fmaxf(mx, 0.f)), 0.f));
            const float d = mnew - mref;
            mref = mnew;
            if (!hi) qx[0] = (short)(pk2(-mref, 0.f) & 0xffffu);
#pragma unroll
            for (int r = 0; r < 16; ++r) { p0[r] -= d; p1[r] -= d; }
            if (!first) { const float alpha = __builtin_amdgcn_exp2f(-d); lsum *= alpha;
#pragma unroll
                for (int r = 0; r < 16; ++r) { o[0][r] *= alpha; o[1][r] *= alpha; } }
        }
        float ps = 0.f;
#pragma unroll
        for (int r = 0; r < 16; ++r) { p0[r] = __builtin_amdgcn_exp2f(p0[r]); p1[r] = __builtin_amdgcn_exp2f(p1[r]); ps += p0[r] + p1[r]; }
        lsum += ps;
        bf16x8 pa[2][2];
#pragma unroll
        for (int ii = 0; ii < 2; ++ii) {
            u32x4 w0, w1;
#pragma unroll
            for (int j = 0; j < 4; ++j) { w0[j] = pk2(p0[8 * ii + 2 * j], p0[8 * ii + 2 * j + 1]); w1[j] = pk2(p1[8 * ii + 2 * j], p1[8 * ii + 2 * j + 1]); }
            pa[0][ii] = __builtin_bit_cast(bf16x8, w0); pa[1][ii] = __builtin_bit_cast(bf16x8, w1);
        }
        const LAS unsigned char* vb_ = Vl + ((4 * hi + trr) * VLD + trc) * 2;
#pragma unroll
        for (int d0 = 0; d0 < 2; ++d0)
#pragma unroll
            for (int kh = 0; kh < 2; ++kh)
#pragma unroll
                for (int ii = 0; ii < 2; ++ii) {
                    const bf16x8 vf = tr_pair(vb_ + ((32 * kh + 16 * ii) * VLD + 32 * d0) * 2, vb_ + ((32 * kh + 16 * ii + 8) * VLD + 32 * d0) * 2);
                    o[d0] = __builtin_amdgcn_mfma_f32_32x32x16_bf16(vf, pa[kh][ii], o[d0], 0, 0, 0);
                }
        if (it + 1 < ntile) ATT_STORE((it + 1) & 1);
        __syncthreads();
    }
#undef ATT_LOAD
#undef ATT_STORE
    const float ltot = lsum + __shfl_xor(lsum, 32);
    const float inv = 1.f / ltot;
    const int ocol = MLA ? 512 + hh * 64 : 768 + (hh * 2 + g) * 64;
    bf16* op = YC + (size_t)tq * DM + ocol + 4 * hi;
#pragma unroll
    for (int d0 = 0; d0 < 2; ++d0)
#pragma unroll
        for (int i4 = 0; i4 < 4; ++i4) {
            u32x2 w; w.x = pk2(o[d0][4 * i4] * inv, o[d0][4 * i4 + 1] * inv); w.y = pk2(o[d0][4 * i4 + 2] * inv, o[d0][4 * i4 + 3] * inv);
            *(u32x2*)(op + 32 * d0 + 8 * i4) = w;
        }
}
__device__ __forceinline__ void phase_attn(CPAR& P, int l, LAS unsigned char* lds, int vcu) {
    for (int u = vcu; u < 768; u += ogx()) {
        bool mla, lat; int b, hh, qb;
        if (u < 256) { mla = true; lat = true; b = u >> 5; hh = (u >> 3) & 3; qb = u & 7; }
        else if (u < 512) { const int v = u - 256; mla = false; lat = true; b = v >> 5; hh = (v >> 4) & 1; qb = v & 15; }
        else if (u < 640) { const int v = u - 512; mla = true; lat = false; b = v >> 2; hh = v & 3; qb = 0; }
        else { const int v = u - 640; mla = false; lat = false; b = v >> 2; hh = (v >> 1) & 1; qb = v & 1; }
        if (mla) attn_unit<true>(P, l, lds, lat, b, hh, qb); else attn_unit<false>(P, l, lds, lat, b, hh, qb);
    }
    __syncthreads();
}

#define XB_TMO      128
#define XB_XCNT(j)  (256  + 64 * (j))
#define XB_XSUB(j)  (1280 + 64 * (j))
#define XB_XGEN(j)  (2304 + 64 * (j))
#define XB_TOP      3328
#define XB_TOPGEN   3392
#define XCD_BAR_WORDS 3456
#define XB_SPIN_CAP (1u << 18)

__device__ __forceinline__ unsigned xb_ld(unsigned* p)              { return __hip_atomic_load(p, __ATOMIC_RELAXED, __HIP_MEMORY_SCOPE_AGENT); }
__device__ __forceinline__ unsigned xb_add(unsigned* p, unsigned v) { return __hip_atomic_fetch_add(p, v, __ATOMIC_RELAXED, __HIP_MEMORY_SCOPE_AGENT); }
__device__ __forceinline__ unsigned xb_xcc_id() { return (unsigned)__builtin_amdgcn_s_getreg((3 << 11) | 20) & 0xFu; }
#define XB_SPIN(cond, bar) do { unsigned _sp = 0; while (cond) { __builtin_amdgcn_s_sleep(1); \
    if ((++_sp & 255u) == 0u) { if (xb_ld(&(bar)[XB_TMO])) break; if (_sp > XB_SPIN_CAP) { atomicAdd(&(bar)[XB_TMO], 1u); break; } } } } while (0)

struct XcdBarrier {
    unsigned* bar; unsigned x;
    volatile LAS unsigned* st;
};

__device__ __forceinline__ XcdBarrier xcd_barrier_post(unsigned* bar, volatile LAS unsigned* st) {
    XcdBarrier b; b.bar = bar; b.x = xb_xcc_id(); b.st = st;
    if (otid() == 0) (void)xb_add(&bar[XB_XCNT(b.x)], 1u);
    return b;
}
__device__ __forceinline__ void xcd_barrier_complete(unsigned* bar, unsigned x, unsigned& nloc, unsigned& nx) {
    const unsigned G = (unsigned)ogx();
    unsigned sum, cnt, mine, sp = 0u;
    for (;;) {
        sum = 0u; cnt = 0u; mine = 0u;
#pragma unroll
        for (unsigned j = 0; j < 16; ++j) { const unsigned c = xb_ld(&bar[XB_XCNT(j)]); sum += c; cnt += (c > 0u) ? 1u : 0u; mine = (j == x) ? c : mine; }
        if (sum == G) break;
        __builtin_amdgcn_s_sleep(1);
        if ((++sp & 255u) == 0u) { if (xb_ld(&bar[XB_TMO])) break; if (sp > XB_SPIN_CAP) { atomicAdd(&bar[XB_TMO], 1u); break; } }
    }
    nloc = mine > 0u ? mine : 1u; nx = cnt > 0u ? cnt : 1u;
}

__device__ __forceinline__ void xcd_barrier(const XcdBarrier& b) {
    asm volatile("s_waitcnt vmcnt(0)" ::: "memory");
    __syncthreads();
    if (otid() == 0) {
        unsigned* bar = b.bar;
        __builtin_amdgcn_s_waitcnt(0);
        unsigned nloc = b.st[0], nx = b.st[1];
        if (nloc == 0u) { xcd_barrier_complete(bar, b.x, nloc, nx); b.st[0] = nloc; b.st[1] = nx; }
        const unsigned old = xb_add(&bar[XB_XSUB(b.x)], 1u);
        const unsigned gen = old / nloc;
        if (old + 1u == (gen + 1u) * nloc) {
            __builtin_amdgcn_fence(__ATOMIC_RELEASE, "agent");
            asm volatile("s_waitcnt vmcnt(0)" ::: "memory");
            const unsigned og = xb_add(&bar[XB_TOP], 1u);
            const unsigned tg = og / nx;
            if (og + 1u == (tg + 1u) * nx) xb_add(&bar[XB_TOPGEN], 1u);
            else XB_SPIN(xb_ld(&bar[XB_TOPGEN]) == tg, bar);
            __builtin_amdgcn_fence(__ATOMIC_ACQUIRE, "agent");
            xb_add(&bar[XB_XGEN(b.x)], 1u);
            asm volatile("s_waitcnt vmcnt(0)" ::: "memory");
        } else {
            XB_SPIN(xb_ld(&bar[XB_XGEN(b.x)]) == gen, bar);
            __builtin_amdgcn_fence(__ATOMIC_ACQUIRE, "agent");
            asm volatile("s_waitcnt vmcnt(0)" ::: "memory");
        }
    }
    __syncthreads();
}

__global__ void __launch_bounds__(512, 2) fwd_kernel(Params Pval) {
    extern __shared__ __attribute__((aligned(16))) unsigned char lds[];
    cg::grid_group grid = cg::this_grid();
    LAS unsigned char* l3 = (LAS unsigned char*)lds;
    volatile LAS unsigned* bst = (volatile LAS unsigned*)(l3 + LDS_BYTES - 64);
    if (otid() == 0) { bst[0] = 0u; bst[1] = 0u; }
    __syncthreads();
    XcdBarrier xbar = xcd_barrier_post((unsigned*)(Pval.ws + WS_BAR), bst);
#ifndef PHMASK
#define PHMASK 0xffff
#endif
#define GETP() CPAR* q_ = (CPAR*)__builtin_amdgcn_kernarg_segment_ptr(); asm volatile("" : "+s"(q_)); CPAR& P = *q_; unsigned char* ws = P.ws; const int G = ogx(), bx = obx(); (void)ws; (void)G; (void)bx;
#ifndef DBLMASK
#define DBLMASK 0
#endif
#ifndef DBLSYNC
#define DBLSYNC 0
#endif
#define RUN(id, ...) do { CPAR* qq_ = (CPAR*)__builtin_amdgcn_kernarg_segment_ptr(); asm volatile("" : "+s"(qq_)); const int lo_ = qq_->ph_lo, hi_ = qq_->ph_hi; \
        if (ph >= lo_ && ph < hi_) { if ((PHMASK >> (id)) & 1) { GETP(); __VA_ARGS__; } if ((DBLMASK >> (id)) & 1) { __syncthreads(); GETP(); __VA_ARGS__; } if (ph + 1 < hi_) { if (ph == 0) grid.sync(); else xcd_barrier(xbar); if (DBLSYNC) xcd_barrier(xbar); } } ++ph; } while (0)
#define RUN_NOSYNC(id, ...) do { CPAR* qq_ = (CPAR*)__builtin_amdgcn_kernarg_segment_ptr(); asm volatile("" : "+s"(qq_)); const int lo_ = qq_->ph_lo, hi_ = qq_->ph_hi; \
        if (ph >= lo_ && ph < hi_) { if ((PHMASK >> (id)) & 1) { GETP(); __VA_ARGS__; } } } while (0)
    int ph = 0;
    RUN(0, phase_mod(P, lds); phase_conv(P, 0, lds, 0, G));
#pragma unroll 1
    for (int l = 0; l < NL; ++l) {
        RUN(1, phase_norm(P, l, 0, l == 0, l > 0 && G == 256));
        RUN(2, { int kq_ = 1024; asm volatile("" : "+s"(kq_)); pg8::Gemm g{(const bf16*)(ws + WS_H), (const bf16*)(ws + (size_t)(l & 1) * WSET + WS_WIN), TT, NZ, kq_, 0}; pg8::StaticOrder S; S.init(TT, NZ, G, bx); EpiStore<0> E{(bf16*)(ws + WS_Z), NZ};
              pg8::gemm_phase<EpiStore<0>, pg8::StaticOrder, true, true>(l3, g, S, E); });
        RUN(3, phase_mid_rows(P, l); phase_mid_sgu(P, l, lds));
        RUN_NOSYNC(5, { int kq_ = 128; asm volatile("" : "+s"(kq_)); pg8::Gemm g{(const bf16*)(ws + WS_CKV), (const bf16*)(ws + (size_t)(l & 1) * WSET + WS_WKV), KVROWS, 512, kq_, 0}; pg8::StaticOrder S; S.init(KVROWS, 512, G, bx); EpiStore<0> E{(bf16*)(ws + WS_KVMLA), 512};
                pg8::gemm_phase<EpiStore<0>, pg8::StaticOrder, true, true>(l3, g, S, E); });
        RUN(12, { int kq_ = 256; asm volatile("" : "+s"(kq_)); pg8::Gemm g{(const bf16*)(ws + WS_CQN), (const bf16*)(ws + (size_t)(l & 1) * WSET + WS_WQ), TT, 512, kq_, 0}; pg8::StaticOrder S; S.init(TT, 512, G, (bx + 128) % G); EpiStore<0> E{(bf16*)(ws + WS_QMLA), 512};
                pg8::gemm_phase<EpiStore<0>, pg8::StaticOrder, true, true>(l3, g, S, E); });
        RUN(6, { const int vcu = (G % 8 == 0) ? (bx % 8) * (G / 8) + bx / 8 : bx; phase_attn(P, l, l3, vcu); });
        RUN(7, { const float* modl = (const float*)(ws + WS_MOD) + (size_t)l * 9 * 6144; int kq_ = 1024; asm volatile("" : "+s"(kq_)); pg8::Gemm g{(const bf16*)(ws + WS_YCAT), (const bf16*)(ws + (size_t)(l & 1) * WSET + WS_WOUT), TT, 1024, kq_, 0}; pg8::StaticOrder S; S.init(TT, 1024, G, bx); EpiRes E{(bf16*)(ws + WS_X16), modl + 2 * 1024, (bf16*)(ws + WS_PART)};
              pg8::gemm_phase<EpiRes, pg8::StaticOrder, true, true>(l3, g, S, E);
              if (l + 1 < NL && bx >= G / 2) phase_conv(P, l + 1, lds, G / 2, G - G / 2); });
        RUN(8, phase_norm(P, l, 1, false, false));
        RUN(9, { int kq_ = 1024; asm volatile("" : "+s"(kq_)); pg8::Gemm g{(const bf16*)(ws + WS_H), (const bf16*)(ws + (size_t)(l & 1) * WSET + WS_W1), TT, HID, kq_, 0}; pg8::StaticOrder S; S.init(TT, HID, G, bx); EpiStore<1> E{(bf16*)(ws + WS_HID), HID};
              pg8::gemm_phase<EpiStore<1>, pg8::StaticOrder, true, true>(l3, g, S, E); });
        RUN_NOSYNC(10, { const float* modl = (const float*)(ws + WS_MOD) + (size_t)l * 9 * 6144; EpiRes E{(bf16*)(ws + WS_X16), modl + 5 * 1024, (bf16*)(ws + WS_PART)};
              if (G == 256) { int kq_ = HID; asm volatile("" : "+s"(kq_)); pg8::Gemm g{(const bf16*)(ws + WS_HID), (const bf16*)(ws + (size_t)(l & 1) * WSET + WS_W2), TT, 1024, kq_, 0}; pg8::TailSplitOrder<0> S; S.init(bx);
                  pg8::gemm_phase<EpiRes, pg8::TailSplitOrder<0>, true, true>(l3, g, S, E); }
              else { int kq_ = HID; asm volatile("" : "+s"(kq_)); pg8::Gemm g{(const bf16*)(ws + WS_HID), (const bf16*)(ws + (size_t)(l & 1) * WSET + WS_W2), TT, 1024, kq_, 0}; pg8::StaticOrder S; S.init(TT, 1024, G, bx);
                  pg8::gemm_phase<EpiRes, pg8::StaticOrder, true, true>(l3, g, S, E); } });
        RUN(10, { const float* modl = (const float*)(ws + WS_MOD) + (size_t)l * 9 * 6144; EpiRes E{(bf16*)(ws + WS_X16), modl + 5 * 1024, (bf16*)(ws + WS_PART)};
              if (G == 256) { int kq_ = HID; asm volatile("" : "+s"(kq_)); int ks_ = HID / 2; asm volatile("" : "+s"(ks_)); pg8::Gemm g{(const bf16*)(ws + WS_HID), (const bf16*)(ws + (size_t)(l & 1) * WSET + WS_W2), TT, 1024, kq_, ks_}; pg8::TailSplitOrder<1> S; S.init(bx);
                  pg8::gemm_phase<EpiRes, pg8::TailSplitOrder<1>, true, true>(l3, g, S, E); } });
    }
    RUN(11, phase_final(P, G == 256));
#undef RUN
#undef GETP
}

extern "C" void kernel_launch(void* const* d_in, const int* in_sizes, int n_in, void* d_out, int out_size, void* d_ws, size_t ws_size, hipStream_t stream) {
    static int grid = 0;
    if (grid == 0) {
        if (n_in != 26 || ws_size < WS_END) { fprintf(stderr, "kernel_launch: unexpected n_in %d or ws_size %zu (< %zu)\n", n_in, ws_size, (size_t)WS_END); grid = -1; return; }
        int dev = 0, cus = 0, per_cu = 0;
        (void)hipGetDevice(&dev);
        (void)hipDeviceGetAttribute(&cus, hipDeviceAttributeMultiprocessorCount, dev);
        if (hipFuncSetAttribute((const void*)fwd_kernel, hipFuncAttributeMaxDynamicSharedMemorySize, LDS_BYTES) != hipSuccess) fprintf(stderr, "kernel_launch: hipFuncSetAttribute failed\n");
        if (hipOccupancyMaxActiveBlocksPerMultiprocessor(&per_cu, (const void*)fwd_kernel, 512, LDS_BYTES) != hipSuccess || per_cu < 1) { fprintf(stderr, "kernel_launch: occupancy query gave %d\n", per_cu); per_cu = 1; }
        (void)hipGetLastError();
        grid = cus * 1;
        fprintf(stderr, "kernel_launch: cus %d per_cu %d grid %d ws %zu\n", cus, per_cu, grid, ws_size);
    }
    if (grid < 0) return;
    if (hipMemsetAsync((char*)d_ws + WS_BAR, 0, XCD_BAR_WORDS * 4, stream) != hipSuccess) fprintf(stderr, "kernel_launch: memset failed\n");
    Params p; memset(&p, 0, sizeof(p));
    for (int i = 0; i < 26; ++i) p.in[i] = (const float*)d_in[i];
    p.out = (float*)d_out; p.ws = (unsigned char*)d_ws; p.ph_lo = 0; p.ph_hi = NPHASE;
    void* args[] = {&p};
    hipError_t e = hipLaunchCooperativeKernel((const void*)fwd_kernel, dim3(grid), dim3(512), args, LDS_BYTES, stream);
    if (e != hipSuccess) fprintf(stderr, "cooperative launch failed: %s (grid %d)\n", hipGetErrorString(e), grid);
}
```
